# Optimizing an MI355X kernel written in HIP

```python
import math
import jax, jax.numpy as jnp
from jax import lax
import numpy as np

D_MODEL = 1024
BATCH = 4
SEQ = 8192
DEPTH = 1

PLE_DIM = 256
NORM_EPS = 1e-6
DA_HEADS = 4
DA_HEAD_DIM = 64
DA_V_DIM = 2 * DA_HEAD_DIM
DA_QK = DA_HEADS * 2 * DA_HEAD_DIM
DA_WIDTH = DA_HEADS * DA_V_DIM
DA_IN_WIDTH = 2 * DA_QK + DA_WIDTH
ROPE_THETA = 500000.0
ROT_DIM = DA_HEAD_DIM // 4
Q_BLOCK = 128
RW_HEAD = 64
RW_WIDTH = D_MODEL - DA_WIDTH
RW_HEADS = RW_WIDTH // RW_HEAD
DECAY_LORA = 64
AAA_LORA = 64
GATE_LORA = 128
RW_IN_WIDTH = 3 * RW_WIDTH + DECAY_LORA + AAA_LORA + GATE_LORA
RW_GN_EPS = 64e-5
IN_WIDTH = DA_IN_WIDTH + RW_IN_WIDTH
PEER_HEADS = 8
N_KEYS = 128
N_EXPERTS = N_KEYS * N_KEYS
PEER_TOPK = 16
PEER_QDIM = 256
PEER_HALF = PEER_QDIM // 2
TOKEN_BLOCK = 128

kernel_name = "hymba_diffattn_rwkv7_peer_block"


def rms_norm(x, g, eps=NORM_EPS):
    xf = x.astype(jnp.float32)
    y = xf * lax.rsqrt(jnp.mean(xf * xf, axis=-1, keepdims=True) + eps)
    return (y * g.astype(jnp.float32)).astype(x.dtype)


def partial_rope(t, positions):
    half = ROT_DIM // 2
    inv_freq = ROPE_THETA ** (-jnp.arange(half, dtype=jnp.float32) * 2.0 / ROT_DIM)
    ang = positions.astype(jnp.float32)[..., None] * inv_freq
    cos = jnp.cos(ang)[:, :, None, None, :]
    sin = jnp.sin(ang)[:, :, None, None, :]
    tf = t.astype(jnp.float32)
    t1 = tf[..., :half]
    t2 = tf[..., half:ROT_DIM]
    out = jnp.concatenate([t1 * cos - t2 * sin, t2 * cos + t1 * sin, tf[..., ROT_DIM:]], axis=-1)
    return out.astype(t.dtype)


def diff_attention(z_da, positions, lam_q1, lam_k1, lam_q2, lam_k2, subln_g, lam_init):
    B, S, _ = z_da.shape
    q, k, v = jnp.split(z_da, [DA_QK, 2 * DA_QK], axis=-1)
    q = partial_rope(q.reshape(B, S, DA_HEADS, 2, DA_HEAD_DIM), positions)
    k = partial_rope(k.reshape(B, S, DA_HEADS, 2, DA_HEAD_DIM), positions)
    q = (q * DA_HEAD_DIM ** -0.5).transpose(0, 2, 3, 1, 4)
    k = k.transpose(0, 2, 3, 1, 4)
    v = v.reshape(B, S, DA_HEADS, DA_V_DIM).transpose(0, 2, 1, 3)
    f32 = jnp.float32
    lam = (jnp.exp(jnp.sum(lam_q1.astype(f32) * lam_k1.astype(f32)))
           - jnp.exp(jnp.sum(lam_q2.astype(f32) * lam_k2.astype(f32))) + lam_init)
    key_pos = jnp.arange(S)

    def block(bi):
        start = bi * Q_BLOCK
        qb = lax.dynamic_slice_in_dim(q, start, Q_BLOCK, axis=3)
        s = jnp.einsum('bhcqd,bhckd->bhcqk', qb, k).astype(f32)
        causal = key_pos[None, :] <= (start + jnp.arange(Q_BLOCK))[:, None]
        pr = jax.nn.softmax(jnp.where(causal, s, -jnp.inf), axis=-1)
        a = pr[:, :, 0] - lam * pr[:, :, 1]
        return jnp.einsum('bhqk,bhkv->bhqv', a.astype(v.dtype), v)

    o = lax.map(block, jnp.arange(S // Q_BLOCK))
    o = o.transpose(1, 0, 3, 2, 4).reshape(B, S, DA_HEADS, DA_V_DIM)
    o = rms_norm(o, subln_g) * (1.0 - lam_init)
    return o.reshape(B, S, DA_WIDTH).astype(z_da.dtype)


def rwkv7_mix(z_rw, mu, w0, w_up, a0, a_up, g_up, k_k, k_a, r_k, ln_g, ln_b):
    B, S, _ = z_rw.shape
    f32 = jnp.float32
    prev = jnp.pad(z_rw[:, :-1], ((0, 0), (1, 0), (0, 0)))
    zs = z_rw + (prev - z_rw) * mu
    o1 = 3 * RW_WIDTH
    r, k, v, xw, xa, xg = jnp.split(
        zs, [RW_WIDTH, 2 * RW_WIDTH, o1, o1 + DECAY_LORA, o1 + DECAY_LORA + AAA_LORA], axis=-1)
    w = -jax.nn.softplus(-(w0 + jnp.tanh(xw) @ w_up)) - 0.5
    a = jax.nn.sigmoid(a0 + xa @ a_up)
    g = jax.nn.sigmoid(xg) @ g_up
    kk = k * k_k
    k = k * (1.0 + (a - 1.0) * k_a)

    def heads(t):
        return t.reshape(B, S, RW_HEADS, RW_HEAD).astype(f32)

    kk = heads(kk)
    kk = kk / jnp.maximum(jnp.sqrt(jnp.sum(kk * kk, axis=-1, keepdims=True)), 1e-12)
    r, k, v, a = heads(r), heads(k), heads(v), heads(a)
    decay = jnp.exp(-jnp.exp(heads(w)))

    def step(state, inp):
        r_t, d_t, k_t, v_t, kk_t, a_t = inp
        sa = jnp.einsum('bhij,bhj->bhi', state, -kk_t)
        state = (state * d_t[:, :, None, :] + sa[..., None] * (kk_t * a_t)[:, :, None, :]
                 + v_t[..., None] * k_t[:, :, None, :])
        return state, jnp.einsum('bhij,bhj->bhi', state, r_t)

    def tm(t):
        return jnp.moveaxis(t, 1, 0)

    s0 = jnp.zeros((B, RW_HEADS, RW_HEAD, RW_HEAD), f32)
    _, y = lax.scan(step, s0, (tm(r), tm(decay), tm(k), tm(v), tm(kk), tm(a)))
    y = jnp.moveaxis(y, 0, 1)
    mean = jnp.mean(y, axis=-1, keepdims=True)
    var = jnp.mean(jnp.square(y - mean), axis=-1, keepdims=True)
    y = ((y - mean) * lax.rsqrt(var + RW_GN_EPS) * ln_g.astype(f32).reshape(RW_HEADS, RW_HEAD)
         + ln_b.astype(f32).reshape(RW_HEADS, RW_HEAD))
    y = y + jnp.sum(r * k * r_k.astype(f32), axis=-1, keepdims=True) * v
    y = y.reshape(B, S, RW_WIDTH) * g.astype(f32)
    return y.astype(z_rw.dtype)


def peer_ffn(u, w_q, sub_keys, exp_u, exp_v):
    B, S, D = u.shape
    f32 = jnp.float32
    tokens = u.reshape(-1, TOKEN_BLOCK, D)

    def block(xc):
        q = (xc @ w_q).reshape(TOKEN_BLOCK, PEER_HEADS, 2, PEER_HALF)
        s = jnp.einsum('chpd,hpnd->chpn', q, sub_keys).astype(f32)
        s_top, i_top = lax.top_k(s, PEER_TOPK)
        cand = (s_top[:, :, 0, :, None] + s_top[:, :, 1, None, :]).reshape(
            TOKEN_BLOCK, PEER_HEADS, PEER_TOPK * PEER_TOPK)
        cand_idx = (i_top[:, :, 0, :, None] * N_KEYS + i_top[:, :, 1, None, :]).reshape(
            TOKEN_BLOCK, PEER_HEADS, PEER_TOPK * PEER_TOPK)
        best, pos = lax.top_k(cand, PEER_TOPK)
        idx = jnp.take_along_axis(cand_idx, pos, axis=-1)
        gate = jax.nn.softmax(best, axis=-1)
        uu = jnp.take(exp_u, idx, axis=0)
        vv = jnp.take(exp_v, idx, axis=0)
        hid = jax.nn.gelu(jnp.einsum('chkd,cd->chk', uu, xc).astype(f32), approximate=False)
        return jnp.einsum('chk,chkd->cd', (gate * hid).astype(vv.dtype), vv)

    out = lax.map(block, tokens)
    return out.reshape(B, S, D).astype(u.dtype)


def setup_inputs(seed: int = 0) -> dict:
    key = jax.random.key(seed)
    ks = iter(jax.random.split(key, 40))
    f32 = jnp.float32
    L, D = DEPTH, D_MODEL

    def nrm(shape, scale):
        return jax.random.normal(next(ks), shape, f32) * scale

    def gain(shape):
        return 1.0 + nrm(shape, 0.02)

    return {
        "x": nrm((BATCH, SEQ, D), 1.0),
        "p": nrm((DEPTH, BATCH, SEQ, PLE_DIM), 1.0),
        "positions": jnp.broadcast_to(jnp.arange(SEQ, dtype=jnp.int32), (BATCH, SEQ)),
        "norm_mix_g": gain((L, D)),
        "w_in": nrm((L, D, IN_WIDTH), D ** -0.5),
        "lam_q1": nrm((L, DA_HEAD_DIM), 0.1),
        "lam_k1": nrm((L, DA_HEAD_DIM), 0.1),
        "lam_q2": nrm((L, DA_HEAD_DIM), 0.1),
        "lam_k2": nrm((L, DA_HEAD_DIM), 0.1),
        "da_subln_g": gain((L, DA_V_DIM)),
        "rw_mu": jax.random.uniform(next(ks), (L, RW_IN_WIDTH), f32),
        "rw_w0": jax.random.uniform(next(ks), (L, RW_WIDTH), f32, -4.0, 1.0),
        "rw_w_up": nrm((L, DECAY_LORA, RW_WIDTH), 0.1 * DECAY_LORA ** -0.5),
        "rw_a0": nrm((L, RW_WIDTH), 0.1),
        "rw_a_up": nrm((L, AAA_LORA, RW_WIDTH), 0.5 * AAA_LORA ** -0.5),
        "rw_g_up": nrm((L, GATE_LORA, RW_WIDTH), GATE_LORA ** -0.5),
        "rw_k_k": 0.85 + nrm((L, RW_WIDTH), 0.05),
        "rw_k_a": 1.0 + nrm((L, RW_WIDTH), 0.05),
        "rw_r_k": nrm((L, RW_HEADS, RW_HEAD), 0.1),
        "rw_ln_g": gain((L, RW_WIDTH)),
        "rw_ln_b": nrm((L, RW_WIDTH), 0.02),
        "w_out": nrm((L, D, D), D ** -0.5),
        "norm_ffn_g": gain((L, D)),
        "peer_w_q": nrm((L, D, PEER_HEADS * PEER_QDIM), D ** -0.5),
        "peer_sub_keys": nrm((L, PEER_HEADS, 2, N_KEYS, PEER_HALF), PEER_HALF ** -0.5),
        "peer_u": nrm((L, N_EXPERTS, D), D ** -0.5),
        "peer_v": nrm((L, N_EXPERTS, D), 0.5 * PEER_HEADS ** -0.5),
        "norm_ple_g": gain((L, D)),
        "ple_gate_w": nrm((L, D, D), D ** -0.5),
        "ple_proj_w": nrm((L, PLE_DIM, D), PLE_DIM ** -0.5),
        "norm_final_g": gain((D,)),
    }


def reference(x, p, positions, norm_mix_g, w_in, lam_q1, lam_k1, lam_q2, lam_k2, da_subln_g,
              rw_mu, rw_w0, rw_w_up, rw_a0, rw_a_up, rw_g_up, rw_k_k, rw_k_a, rw_r_k,
              rw_ln_g, rw_ln_b, w_out, norm_ffn_g, peer_w_q, peer_sub_keys, peer_u, peer_v,
              norm_ple_g, ple_gate_w, ple_proj_w, norm_final_g):
    h = x
    for i in range(DEPTH):
        u = rms_norm(h, norm_mix_g[i])
        z = u @ w_in[i]
        lam_init = 0.8 - 0.6 * math.exp(-0.3 * i)
        o_da = diff_attention(z[..., :DA_IN_WIDTH], positions, lam_q1[i], lam_k1[i],
                              lam_q2[i], lam_k2[i], da_subln_g[i], lam_init)
        o_rw = rwkv7_mix(z[..., DA_IN_WIDTH:], rw_mu[i], rw_w0[i], rw_w_up[i], rw_a0[i],
                         rw_a_up[i], rw_g_up[i], rw_k_k[i], rw_k_a[i], rw_r_k[i],
                         rw_ln_g[i], rw_ln_b[i])
        h = h + jnp.concatenate([o_da, o_rw], axis=-1) @ w_out[i]
        h = h + peer_ffn(rms_norm(h, norm_ffn_g[i]), peer_w_q[i], peer_sub_keys[i],
                         peer_u[i], peer_v[i])
        gate = jax.nn.sigmoid(rms_norm(h, norm_ple_g[i]) @ ple_gate_w[i])
        h = h + gate * (p[i] @ ple_proj_w[i])
    return rms_norm(h, norm_final_g)
```

```cpp
#include <hip/hip_runtime.h>
#include <hip/hip_cooperative_groups.h>
#include <stdint.h>
#include <math.h>
namespace cg = cooperative_groups;

#define DI __device__ __forceinline__
#define ONE_LAUNCH 1
typedef unsigned short u16;
typedef unsigned int u32;
typedef __attribute__((ext_vector_type(4))) unsigned u32x4;
typedef __attribute__((ext_vector_type(2))) unsigned u32x2;
typedef __attribute__((ext_vector_type(8))) short bf16x8;
typedef __attribute__((ext_vector_type(4))) short s16x4;
typedef __attribute__((ext_vector_type(16))) float f32x16;
typedef __attribute__((ext_vector_type(2))) float f32x2;
typedef __attribute__((ext_vector_type(4))) float f32x4;
typedef __attribute__((ext_vector_type(2))) __bf16 bf16x2;
typedef const float __attribute__((address_space(4)))* cfptr;

constexpr int T_ = 32768, S_ = 8192, TH_ = 16384;
constexpr int CH_L = 128;
constexpr int CH_C = S_ / CH_L;
constexpr int NPHASE = 17;

constexpr size_t MiB = 1u << 20;
constexpr size_t OFF_WINT = 0;
constexpr size_t OFF_WOUTT = 7 * MiB;
constexpr size_t OFF_WQT = 9 * MiB;
constexpr size_t OFF_WGT = 13 * MiB;
constexpr size_t OFF_WPT = 15 * MiB;
constexpr size_t OFF_WLT = 15 * MiB + 512 * 1024;
constexpr size_t OFF_SUBK = 16 * MiB + 512 * 1024;
constexpr size_t OFF_ROPE = 17 * MiB;
constexpr size_t OFF_CTR = 19 * MiB;
constexpr size_t OFF_ACT = 20 * MiB;
constexpr size_t OFF_QK = 84 * MiB;
constexpr size_t OFF_VT = 148 * MiB;
constexpr size_t OFF_ZRW = 180 * MiB;
constexpr size_t OFF_V = 292 * MiB;
constexpr size_t OFF_AL = 356 * MiB;
constexpr size_t OFF_DD = 420 * MiB;
constexpr size_t OFF_L16 = 388 * MiB;
constexpr size_t OFF_PM = 100 * MiB;
constexpr size_t OFF_HM = 132 * MiB;
constexpr size_t OFF_BE = 180 * MiB;
constexpr size_t OFF_G16 = 244 * MiB;
constexpr size_t OFF_Q16 = 84 * MiB;
constexpr size_t OFF_ST = 148 * MiB;
constexpr size_t OFF_IDX = 276 * MiB;
constexpr size_t OFF_GATE = 292 * MiB;
constexpr size_t OFF_PU16 = 484 * MiB;
constexpr size_t OFF_PV16 = 340 * MiB;
constexpr size_t OFF_P16 = 468 * MiB;

struct Params {
  const float *x, *p; const int* pos;
  const float *norm_mix_g, *w_in, *lam_q1, *lam_k1, *lam_q2, *lam_k2, *subln_g;
  const float *rw_mu, *rw_w0, *rw_w_up, *rw_a0, *rw_a_up, *rw_g_up, *rw_k_k, *rw_k_a, *rw_r_k, *rw_ln_g, *rw_ln_b;
  const float *w_out, *norm_ffn_g, *peer_w_q, *peer_sub_keys, *peer_u, *peer_v, *norm_ple_g, *ple_gate_w, *ple_proj_w, *norm_final_g;
  float* out; char* ws;
  float inv_freq[8];
  int ph_lo, ph_hi;
};

DI u32 pack2(float a, float b) { f32x2 v = {a, b}; bf16x2 r = __builtin_convertvector(v, bf16x2); return __builtin_bit_cast(u32, r); }
DI u16 f2bf(float a) { return (u16)(pack2(a, 0.f) & 0xffffu); }
DI float bflo(u32 v) { return __uint_as_float(v << 16); }
DI float bfhi(u32 v) { return __uint_as_float(v & 0xffff0000u); }
DI f32x16 mfma32(bf16x8 a, bf16x8 b, f32x16 c) { return __builtin_amdgcn_mfma_f32_32x32x16_bf16(a, b, c, 0, 0, 0); }
DI int crow(int i, int h) { return (i & 3) + 8 * (i >> 2) + 4 * h; }
template <int CTRL> DI float dppf(float x) { return __int_as_float(__builtin_amdgcn_update_dpp(0, __float_as_int(x), CTRL, 0xf, 0xf, false)); }
DI float sum8(float x) { x += dppf<0xB1>(x); x += dppf<0x4E>(x); x += dppf<0x141>(x); return x; }
DI float rlf(float x, int l) { return __int_as_float(__builtin_amdgcn_readlane(__float_as_int(x), l)); }
DI float wave_sum(float x) {
  x = sum8(x); x += dppf<0x140>(x);
  return (rlf(x, 0) + rlf(x, 16)) + (rlf(x, 32) + rlf(x, 48));
}
DI float xor32(float x) { return __shfl_xor(x, 32); }
DI cfptr to_const(const float* p) { return (cfptr)(uintptr_t)p; }
DI float sigmoidf_(float x) { return 1.f / (1.f + __expf(-x)); }
DI float dot8(u32x4 a, u32x4 b, float acc) {
  acc = fmaf(bflo(a.x), bflo(b.x), acc); acc = fmaf(bfhi(a.x), bfhi(b.x), acc);
  acc = fmaf(bflo(a.y), bflo(b.y), acc); acc = fmaf(bfhi(a.y), bfhi(b.y), acc);
  acc = fmaf(bflo(a.z), bflo(b.z), acc); acc = fmaf(bfhi(a.z), bfhi(b.z), acc);
  acc = fmaf(bflo(a.w), bflo(b.w), acc); acc = fmaf(bfhi(a.w), bfhi(b.w), acc);
  return acc;
}

constexpr int LDS_LD = 72;
constexpr int G_BUF = 2 * 128 * LDS_LD;
DI void gemm_tile(f32x16 (&acc)[2][2], const u16* Wt, int ldw, const u16* X, int ldx, int K, u16* sW, u16* sX) {
  const int tid = threadIdx.x, lane = tid & 63, wave = tid >> 6;
  const int wn = wave >> 1, wm = wave & 1, r = lane & 31, h = lane >> 5;
  const u16* gw = Wt + (size_t)(tid >> 3) * ldw + (tid & 7) * 8;
  const u16* gx = X + (size_t)(tid >> 3) * ldx + (tid & 7) * 8;
  u16* lw = sW + (tid >> 3) * LDS_LD + (tid & 7) * 8;
  u16* lx = sX + (tid >> 3) * LDS_LD + (tid & 7) * 8;
  const size_t sw32 = (size_t)32 * ldw, sx32 = (size_t)32 * ldx;
  const u16* pa = sW + (wn * 64 + r) * LDS_LD + h * 8;
  const u16* pb = sX + (wm * 64 + r) * LDS_LD + h * 8;
  const int nk = K >> 6;
  u32x4 r0w[4], r0x[4], r1w[4], r1x[4];
#define G_LOAD(RW, RX, kt) { _Pragma("unroll") for (int i = 0; i < 4; ++i) { RW[i] = *(const u32x4*)(gw + i * sw32 + (kt) * 64); RX[i] = *(const u32x4*)(gx + i * sx32 + (kt) * 64); } }
#define G_STORE(RW, RX, st) { _Pragma("unroll") for (int i = 0; i < 4; ++i) { *(u32x4*)(lw + (st) * G_BUF + i * 32 * LDS_LD) = RW[i]; *(u32x4*)(lx + (st) * G_BUF + i * 32 * LDS_LD) = RX[i]; } }
#define G_COMPUTE(st) { _Pragma("unroll") for (int ks = 0; ks < 4; ++ks) { bf16x8 a[2], b[2]; \
    _Pragma("unroll") for (int i = 0; i < 2; ++i) { a[i] = *(const bf16x8*)(pa + (st) * G_BUF + i * 32 * LDS_LD + ks * 16); b[i] = *(const bf16x8*)(pb + (st) * G_BUF + i * 32 * LDS_LD + ks * 16); } \
    _Pragma("unroll") for (int i = 0; i < 2; ++i) _Pragma("unroll") for (int jj = 0; jj < 2; ++jj) acc[i][jj] = mfma32(a[i], b[jj], acc[i][jj]); } }
  G_LOAD(r0w, r0x, 0)
  __syncthreads();
  G_STORE(r0w, r0x, 0)
  G_LOAD(r0w, r0x, 1)
  if (nk > 2) G_LOAD(r1w, r1x, 2)
  __syncthreads();
  for (int k = 0; k < nk; k += 2) {
    G_COMPUTE(0)
    G_STORE(r0w, r0x, 1)
    if (k + 3 < nk) G_LOAD(r0w, r0x, k + 3)
    __syncthreads();
    G_COMPUTE(1)
    if (k + 2 < nk) {
      G_STORE(r1w, r1x, 0)
      if (k + 4 < nk) G_LOAD(r1w, r1x, k + 4)
      __syncthreads();
    }
  }
#undef G_LOAD
#undef G_STORE
#undef G_COMPUTE
}
DI void zero_acc(f32x16 (&acc)[2][2]) {
#pragma unroll
  for (int i = 0; i < 2; ++i)
#pragma unroll
    for (int j = 0; j < 2; ++j)
#pragma unroll
      for (int k = 0; k < 16; ++k) acc[i][j][k] = 0.f;
}

DI void transpose_tile(const float* src, int N, int kt, int nt, u16* dst, int ldd, int kofs, bool valid, float* tile) {
  const int tid = threadIdx.x;
  if (valid) {
#pragma unroll 4
    for (int i = 0; i < 16; ++i) {
      int idx = tid + 256 * i, kk = idx >> 6, nn = idx & 63;
      tile[kk * 65 + nn] = src[(size_t)(kt * 64 + kk) * N + nt * 64 + nn];
    }
  }
  __syncthreads();
#pragma unroll 4
  for (int i = 0; i < 16; ++i) {
    int idx = tid + 256 * i, nn = idx >> 6, kk = idx & 63;
    float v = valid ? tile[kk * 65 + nn] : 0.f;
    dst[(size_t)(nt * 64 + nn) * ldd + kofs + kt * 64 + kk] = f2bf(v);
  }
  __syncthreads();
}
DI void transpose_all(const float* src, int K, int N, u16* dst, float* tile) {
  int KT = K / 64, NTt = N / 64;
  for (int t = blockIdx.x; t < KT * NTt; t += gridDim.x) transpose_tile(src, N, t % KT, t / KT, dst, K, 0, true, tile);
}
DI void convert_flat(const float* src, u16* dst, size_t n) {
  size_t n4 = n / 4;
  for (size_t i = (size_t)blockIdx.x * 256 + threadIdx.x; i < n4; i += (size_t)gridDim.x * 256) {
    float4 v = ((const float4*)src)[i];
    u32x2 o = {pack2(v.x, v.y), pack2(v.z, v.w)};
    ((u32x2*)dst)[i] = o;
  }
}
DI void convert_fp8(const float* src, unsigned char* dst, size_t n, float scale) {
  size_t n8 = n / 8;
  for (size_t i = (size_t)blockIdx.x * 256 + threadIdx.x; i < n8; i += (size_t)gridDim.x * 256) {
    float4 a = ((const float4*)src)[2 * i], b = ((const float4*)src)[2 * i + 1];
    int r0 = __builtin_amdgcn_cvt_pk_fp8_f32(a.x * scale, a.y * scale, 0, false);
    r0 = __builtin_amdgcn_cvt_pk_fp8_f32(a.z * scale, a.w * scale, r0, true);
    int r1 = __builtin_amdgcn_cvt_pk_fp8_f32(b.x * scale, b.y * scale, 0, false);
    r1 = __builtin_amdgcn_cvt_pk_fp8_f32(b.z * scale, b.w * scale, r1, true);
    u32x2 o = {(u32)r0, (u32)r1};
    ((u32x2*)dst)[i] = o;
  }
}
DI void convert_fp4(const float* src, unsigned char* dst, size_t n, float scale) {
  size_t n8 = n / 8;
  for (size_t i = (size_t)blockIdx.x * 256 + threadIdx.x; i < n8; i += (size_t)gridDim.x * 256) {
    float4 a = ((const float4*)src)[2 * i], b = ((const float4*)src)[2 * i + 1];
    u32 r = 0u;
    r = __builtin_amdgcn_cvt_scalef32_pk_fp4_f32(r, a.x * scale, a.y * scale, 1.0f, 0);
    r = __builtin_amdgcn_cvt_scalef32_pk_fp4_f32(r, a.z * scale, a.w * scale, 1.0f, 1);
    r = __builtin_amdgcn_cvt_scalef32_pk_fp4_f32(r, b.x * scale, b.y * scale, 1.0f, 2);
    r = __builtin_amdgcn_cvt_scalef32_pk_fp4_f32(r, b.z * scale, b.w * scale, 1.0f, 3);
    ((u32*)dst)[i] = r;
  }
}
DI void fp4x8_to_f32(u32 w, float* f) {
  f32x2 p0 = __builtin_amdgcn_cvt_scalef32_pk_f32_fp4(w, 1.0f, 0), p1 = __builtin_amdgcn_cvt_scalef32_pk_f32_fp4(w, 1.0f, 1);
  f32x2 p2 = __builtin_amdgcn_cvt_scalef32_pk_f32_fp4(w, 1.0f, 2), p3 = __builtin_amdgcn_cvt_scalef32_pk_f32_fp4(w, 1.0f, 3);
  f[0] = p0.x; f[1] = p0.y; f[2] = p1.x; f[3] = p1.y; f[4] = p2.x; f[5] = p2.y; f[6] = p3.x; f[7] = p3.y;
}
DI u32 pack_fp4x8(const float4 a, const float4 b, float scale) {
  u32 r = 0u;
  r = __builtin_amdgcn_cvt_scalef32_pk_fp4_f32(r, a.x * scale, a.y * scale, 1.0f, 0);
  r = __builtin_amdgcn_cvt_scalef32_pk_fp4_f32(r, a.z * scale, a.w * scale, 1.0f, 1);
  r = __builtin_amdgcn_cvt_scalef32_pk_fp4_f32(r, b.x * scale, b.y * scale, 1.0f, 2);
  r = __builtin_amdgcn_cvt_scalef32_pk_fp4_f32(r, b.z * scale, b.w * scale, 1.0f, 3);
  return r;
}
DI void convert_uv_fp4(const float* u, const float* v, unsigned char* dst, float su, float sv, int b0) {
  const size_t n = (size_t)16384 * 64;
  if ((int)blockIdx.x < b0) return;
  for (size_t i = (size_t)(blockIdx.x - b0) * 256 + threadIdx.x; i < n; i += (size_t)(gridDim.x - b0) * 256) {
    const float4* pu = (const float4*)(u + i * 16); const float4* pv = (const float4*)(v + i * 16);
    u32x4 o = {pack_fp4x8(pu[0], pu[1], su), pack_fp4x8(pu[2], pu[3], su), pack_fp4x8(pv[0], pv[1], sv), pack_fp4x8(pv[2], pv[3], sv)};
    ((u32x4*)dst)[i] = o;
  }
}
DI void rmsnorm_rows(const float* src, const float* g, u16* dst) {
  const int lane = threadIdx.x & 63, wave = threadIdx.x >> 6;
  for (int t = blockIdx.x * 4 + wave; t < T_; t += gridDim.x * 4) {
    const float4* row = (const float4*)(src + (size_t)t * 1024);
    float4 v[4]; float ss = 0.f;
#pragma unroll
    for (int i = 0; i < 4; ++i) { v[i] = row[lane + 64 * i]; ss += v[i].x * v[i].x + v[i].y * v[i].y + v[i].z * v[i].z + v[i].w * v[i].w; }
    ss = wave_sum(ss);
    float rs = rsqrtf(ss * (1.f / 1024.f) + 1e-6f);
#pragma unroll
    for (int i = 0; i < 4; ++i) {
      float4 gg = ((const float4*)g)[lane + 64 * i];
      u32x2 o = {pack2(v[i].x * rs * gg.x, v[i].y * rs * gg.y), pack2(v[i].z * rs * gg.z, v[i].w * rs * gg.w)};
      ((u32x2*)(dst + (size_t)t * 1024))[lane + 64 * i] = o;
    }
  }
}
DI void phase_prep(const Params& P, char* smem) {
  float* tile = (float*)smem;
  char* ws = P.ws;
  transpose_all(P.w_in, 1024, 3328, (u16*)(ws + OFF_WINT), tile);
  transpose_all(P.w_out, 1024, 1024, (u16*)(ws + OFF_WOUTT), tile);
  transpose_all(P.peer_w_q, 1024, 2048, (u16*)(ws + OFF_WQT), tile);
  transpose_all(P.ple_gate_w, 1024, 1024, (u16*)(ws + OFF_WGT), tile);
  transpose_all(P.ple_proj_w, 256, 1024, (u16*)(ws + OFF_WPT), tile);
  for (int t = blockIdx.x; t < 24 * 4; t += gridDim.x) {
    int nt = t >> 2, kt = t & 3, sec = nt >> 3, ntl = nt & 7;
    const float* src; int kts; bool valid;
    if (sec == 0) { src = P.rw_w_up; valid = (kt == 0); kts = 0; }
    else if (sec == 1) { src = P.rw_a_up; valid = (kt == 1); kts = 0; }
    else { src = P.rw_g_up; valid = (kt >= 2); kts = kt - 2; }
    transpose_tile(src, 512, kts, ntl, (u16*)(ws + OFF_WLT) + (size_t)sec * 512 * 256, 256, (kt - kts) * 64, valid, tile);
  }
  convert_flat(P.peer_sub_keys, (u16*)(ws + OFF_SUBK), (size_t)16 * 128 * 128);
  float2* rope = (float2*)(ws + OFF_ROPE);
  for (int i = blockIdx.x * 256 + threadIdx.x; i < T_ * 8; i += gridDim.x * 256) {
    int m = i >> 3, f = i & 7;
    float ang = (float)P.pos[m] * P.inv_freq[f];
    double a = (double)ang;
    double k = rint(a * 0.15915494309189535);
    float rr = (float)(a - k * 6.283185307179586);
    rope[i] = make_float2(__cosf(rr), __sinf(rr));
  }
  rmsnorm_rows(P.x, P.norm_mix_g, (u16*)(ws + OFF_ACT));
}

DI void phase_gemm1(const Params& P, char* smem) {
  u16* sW = (u16*)smem; u16* sX = sW + 128 * LDS_LD;
  char* ws = P.ws;
  const u16* WinT = (const u16*)(ws + OFF_WINT); const u16* ACT = (const u16*)(ws + OFF_ACT);
  const float2* rope = (const float2*)(ws + OFF_ROPE);
  u16* QK = (u16*)(ws + OFF_QK); u16* VT = (u16*)(ws + OFF_VT); u16* ZRW = (u16*)(ws + OFF_ZRW);
  const int lane = threadIdx.x & 63, wave = threadIdx.x >> 6, wn = wave >> 1, wm = wave & 1, r = lane & 31, h = lane >> 5;
  constexpr int NT = 26, MT = 256;
  for (int tile = blockIdx.x; tile < NT * MT; tile += gridDim.x) {
    int mt = tile / NT, nt = tile % NT;
    f32x16 acc[2][2]; zero_acc(acc);
    gemm_tile(acc, WinT + (size_t)nt * 128 * 1024, 1024, ACT + (size_t)mt * 128 * 1024, 1024, 1024, sW, sX);
#pragma unroll
    for (int ai = 0; ai < 2; ++ai)
#pragma unroll
      for (int bi = 0; bi < 2; ++bi) {
        const int nb = nt * 128 + wn * 64 + ai * 32;
        const int m = mt * 128 + wm * 64 + bi * 32 + r;
        f32x16 v = acc[ai][bi];
        if (nb < 1024) {
          if ((nb & 63) == 0) {
#pragma unroll
            for (int i = 0; i < 4; ++i) {
              float2 cs = rope[m * 8 + 4 * h + i];
              float t1 = v[i], t2 = v[i + 4];
              v[i] = t1 * cs.x - t2 * cs.y; v[i + 4] = t2 * cs.x + t1 * cs.y;
            }
          }
          if (nb < 512) {
#pragma unroll
            for (int i = 0; i < 16; ++i) v[i] *= 0.125f;
          }
#pragma unroll
          for (int q = 0; q < 4; ++q) {
            u32x2 pk = {pack2(v[4 * q], v[4 * q + 1]), pack2(v[4 * q + 2], v[4 * q + 3])};
            *(u32x2*)(QK + (size_t)m * 1024 + nb + 8 * q + 4 * h) = pk;
          }
        } else if (nb < 1536) {
          const int hh = (nb - 1024) >> 7, dv0 = (nb - 1024) & 127, b = m >> 13, s = m & 8191;
#pragma unroll
          for (int i = 0; i < 16; ++i) VT[((size_t)((b * 4 + hh) * 128 + dv0 + crow(i, h))) * S_ + s] = f2bf(v[i]);
        } else {
#pragma unroll
          for (int q = 0; q < 4; ++q) {
            u32x2 pk = {pack2(v[4 * q], v[4 * q + 1]), pack2(v[4 * q + 2], v[4 * q + 3])};
            *(u32x2*)(ZRW + (size_t)m * 1792 + (nb - 1536) + 8 * q + 4 * h) = pk;
          }
        }
      }
  }
}

DI void phase_attn(const Params& P, char* smem) {
  constexpr int ATT_BUF = (64 + 128) * LDS_LD;
  u16* sK = (u16*)smem;
  u16* sV = sK + 64 * LDS_LD;
  int* sItem = (int*)(sK + 2 * ATT_BUF);
  char* ws = P.ws;
  const u16* QK = (const u16*)(ws + OFF_QK); const u16* VT = (const u16*)(ws + OFF_VT);
  u16* CAT = (u16*)(ws + OFF_ACT);
  unsigned* ctr = (unsigned*)(ws + OFF_CTR);
  const int tid = threadIdx.x, lane = tid & 63, wave = tid >> 6, r = lane & 31, h = lane >> 5;
  float d1 = 0.f, d2 = 0.f;
  for (int i = 0; i < 64; ++i) { d1 += P.lam_q1[i] * P.lam_k1[i]; d2 += P.lam_q2[i] * P.lam_k2[i]; }
  const float lam = expf(d1) - expf(d2) + 0.2f;
  const float LOG2E = 1.4426950408889634f;
  for (;;) {
    __syncthreads();
    if (tid == 0) *sItem = (int)atomicAdd(ctr, 1u);
    __syncthreads();
    const int item = *sItem;
    if (item >= 1024) break;
    const int qt = 63 - (item >> 4), bh = item & 15, b = bh >> 2, hh = bh & 3;
    const int qlo = qt * 128 + wave * 32;
    const size_t mq = (size_t)b * S_ + qlo + r;
    const int ntiles = 2 * qt + 2;
    float4* scr = (float4*)(ws + 324 * MiB) + (size_t)blockIdx.x * 16 * 256 + tid;
#pragma unroll
    for (int c = 0; c < 2; ++c) {
      bf16x8 qf[4];
#pragma unroll
      for (int ks = 0; ks < 4; ++ks) qf[ks] = *(const bf16x8*)(QK + mq * 1024 + hh * 128 + c * 64 + ks * 16 + h * 8);
      f32x16 o[4];
#pragma unroll
      for (int d = 0; d < 4; ++d)
#pragma unroll
        for (int i = 0; i < 16; ++i) o[d][i] = 0.f;
      float mrow = -1e30f, lsum = 0.f;
      const u16* kbase = QK + ((size_t)b * S_) * 1024 + 512 + hh * 128 + c * 64;
      const u16* vbase = VT + ((size_t)(b * 4 + hh) * 128) * S_;
      u32x4 rk[2], rv[4];
#pragma unroll
      for (int i = 0; i < 2; ++i) { int cc = tid + 256 * i, row = cc >> 3, kc = cc & 7; rk[i] = *(const u32x4*)(kbase + (size_t)row * 1024 + kc * 8); }
#pragma unroll
      for (int i = 0; i < 4; ++i) { int cc = tid + 256 * i, row = cc >> 3, kc = cc & 7; rv[i] = *(const u32x4*)(vbase + (size_t)row * S_ + kc * 8); }
      __syncthreads();
#pragma unroll
      for (int i = 0; i < 2; ++i) { int cc = tid + 256 * i, row = cc >> 3, kc = cc & 7; *(u32x4*)(sK + row * LDS_LD + kc * 8) = rk[i]; }
#pragma unroll
      for (int i = 0; i < 4; ++i) { int cc = tid + 256 * i, row = cc >> 3, kc = cc & 7; *(u32x4*)(sV + row * LDS_LD + kc * 8) = rv[i]; }
      __syncthreads();
      for (int j = 0; j < ntiles; ++j) {
        const int cur = j & 1;
        const u16* sKc = sK + cur * ATT_BUF; const u16* sVc = sV + cur * ATT_BUF;
        u16* sKn = sK + (cur ^ 1) * ATT_BUF; u16* sVn = sV + (cur ^ 1) * ATT_BUF;
        const bool more = (j + 1 < ntiles);
        if (more) {
          const int k0 = (j + 1) * 64;
#pragma unroll
          for (int i = 0; i < 2; ++i) { int cc = tid + 256 * i, row = cc >> 3, kc = cc & 7; rk[i] = *(const u32x4*)(kbase + (size_t)(k0 + row) * 1024 + kc * 8); }
#pragma unroll
          for (int i = 0; i < 4; ++i) { int cc = tid + 256 * i, row = cc >> 3, kc = cc & 7; rv[i] = *(const u32x4*)(vbase + (size_t)row * S_ + k0 + kc * 8); }
        }
        f32x16 st[2];
        float mnew = 0.f;
        const int key0 = j * 64;
        if (key0 <= qlo + 31) {
#pragma unroll
          for (int kb = 0; kb < 2; ++kb) {
#pragma unroll
            for (int i = 0; i < 16; ++i) st[kb][i] = 0.f;
#pragma unroll
            for (int ks = 0; ks < 4; ++ks) {
              bf16x8 kf = *(const bf16x8*)(sKc + (kb * 32 + r) * LDS_LD + ks * 16 + h * 8);
              st[kb] = mfma32(kf, qf[ks], st[kb]);
            }
          }
          const bool need_mask = (key0 + 63 > qlo);
          float mx = -1e30f;
#pragma unroll
          for (int kb = 0; kb < 2; ++kb)
#pragma unroll
            for (int i = 0; i < 16; ++i) {
              float s = st[kb][i] * LOG2E;
              if (need_mask) { int key = key0 + kb * 32 + crow(i, h); if (key > qlo + r) s = -1e30f; }
              st[kb][i] = s; mx = fmaxf(mx, s);
            }
          mx = fmaxf(mx, xor32(mx));
          mnew = fmaxf(mrow, mx);
          const float alpha = __builtin_amdgcn_exp2f(mrow - mnew);
          mrow = mnew;
          float ps = 0.f;
#pragma unroll
          for (int kb = 0; kb < 2; ++kb)
#pragma unroll
            for (int i = 0; i < 16; ++i) { float p = __builtin_amdgcn_exp2f(st[kb][i] - mnew); st[kb][i] = p; ps += p; }
          lsum = lsum * alpha + ps;
#pragma unroll
          for (int d = 0; d < 4; ++d)
#pragma unroll
            for (int i = 0; i < 16; ++i) o[d][i] *= alpha;
        }
        if (more) {
#pragma unroll
          for (int i = 0; i < 2; ++i) { int cc = tid + 256 * i, row = cc >> 3, kc = cc & 7; *(u32x4*)(sKn + row * LDS_LD + kc * 8) = rk[i]; }
#pragma unroll
          for (int i = 0; i < 4; ++i) { int cc = tid + 256 * i, row = cc >> 3, kc = cc & 7; *(u32x4*)(sVn + row * LDS_LD + kc * 8) = rv[i]; }
        }
        if (key0 <= qlo + 31) {
#pragma unroll
          for (int kb = 0; kb < 2; ++kb)
#pragma unroll
            for (int s = 0; s < 2; ++s) {
              u32x4 pp = {pack2(st[kb][8 * s], st[kb][8 * s + 1]), pack2(st[kb][8 * s + 2], st[kb][8 * s + 3]),
                          pack2(st[kb][8 * s + 4], st[kb][8 * s + 5]), pack2(st[kb][8 * s + 6], st[kb][8 * s + 7])};
              bf16x8 pf = __builtin_bit_cast(bf16x8, pp);
#pragma unroll
              for (int d = 0; d < 4; ++d) {
                const u16* vp = sVc + (d * 32 + r) * LDS_LD + kb * 32 + 16 * s + 4 * h;
                s16x4 lo = *(const s16x4*)vp, hi = *(const s16x4*)(vp + 8);
                bf16x8 vf = __builtin_shufflevector(lo, hi, 0, 1, 2, 3, 4, 5, 6, 7);
                o[d] = mfma32(vf, pf, o[d]);
              }
            }
        }
        __syncthreads();
      }
      const float ltot = lsum + xor32(lsum);
      const float inv = 1.f / ltot;
      if (c == 0) {
#pragma unroll
        for (int d = 0; d < 4; ++d)
#pragma unroll
          for (int q = 0; q < 4; ++q) scr[(d * 4 + q) * 256] = make_float4(o[d][4 * q] * inv, o[d][4 * q + 1] * inv, o[d][4 * q + 2] * inv, o[d][4 * q + 3] * inv);
      } else {
        float ss = 0.f;
        const float li = lam * inv;
#pragma unroll
        for (int d = 0; d < 4; ++d)
#pragma unroll
          for (int q = 0; q < 4; ++q) {
            float4 p0 = scr[(d * 4 + q) * 256];
            float v0 = p0.x - li * o[d][4 * q], v1 = p0.y - li * o[d][4 * q + 1], v2 = p0.z - li * o[d][4 * q + 2], v3 = p0.w - li * o[d][4 * q + 3];
            o[d][4 * q] = v0; o[d][4 * q + 1] = v1; o[d][4 * q + 2] = v2; o[d][4 * q + 3] = v3;
            ss += v0 * v0 + v1 * v1 + v2 * v2 + v3 * v3;
          }
        ss += xor32(ss);
        const float rs = rsqrtf(ss * (1.f / 128.f) + 1e-6f) * 0.8f;
#pragma unroll
        for (int d = 0; d < 4; ++d)
#pragma unroll
          for (int q = 0; q < 4; ++q) {
            const int dv = d * 32 + 8 * q + 4 * h;
            float4 g = *(const float4*)(P.subln_g + dv);
            u32x2 pk = {pack2(o[d][4 * q] * rs * g.x, o[d][4 * q + 1] * rs * g.y), pack2(o[d][4 * q + 2] * rs * g.z, o[d][4 * q + 3] * rs * g.w)};
            *(u32x2*)(CAT + mq * 1024 + hh * 128 + dv) = pk;
          }
      }
    }
  }
}

DI void load8(const u16* p, float (&f)[8]) {
  u32x4 v = *(const u32x4*)p;
  f[0] = bflo(v.x); f[1] = bfhi(v.x); f[2] = bflo(v.y); f[3] = bfhi(v.y); f[4] = bflo(v.z); f[5] = bfhi(v.z); f[6] = bflo(v.w); f[7] = bfhi(v.w);
}
DI void shift8(const u16* zc, bool first, const float* mu, float (&z)[8]) {
  float c[8], p[8];
  load8(zc, c);
  if (first) { for (int e = 0; e < 8; ++e) p[e] = 0.f; } else load8(zc - 1792, p);
  float4 m0 = *(const float4*)mu, m1 = *(const float4*)(mu + 4);
  float mm[8] = {m0.x, m0.y, m0.z, m0.w, m1.x, m1.y, m1.z, m1.w};
#pragma unroll
  for (int e = 0; e < 8; ++e) z[e] = c[e] + (p[e] - c[e]) * mm[e];
}
DI void store8h(u16* dst, const float (&z)[8]) {
  u32x4 o = {pack2(z[0], z[1]), pack2(z[2], z[3]), pack2(z[4], z[5]), pack2(z[6], z[7])};
  *(u32x4*)dst = o;
}
DI void store8f(float* dst, const float (&z)[8]) {
  *(float4*)dst = make_float4(z[0], z[1], z[2], z[3]); *(float4*)(dst + 4) = make_float4(z[4], z[5], z[6], z[7]);
}
DI void phase_rwprep(const Params& P) {
  char* ws = P.ws;
  const u16* ZRW = (const u16*)(ws + OFF_ZRW);
  u16* Rb = (u16*)P.out; u16* Kb = (u16*)P.out + (size_t)T_ * 512;
  u16* Vb = (u16*)(ws + OFF_V); u16* ALb = (u16*)(ws + OFF_AL); u16* L16 = (u16*)(ws + OFF_L16);
  const int lane = threadIdx.x & 63, wave = threadIdx.x >> 6;
  for (int t = blockIdx.x * 4 + wave; t < T_; t += gridDim.x * 4) {
    const bool first = (t & (S_ - 1)) == 0;
    const u16* zc = ZRW + (size_t)t * 1792;
    float z[8];
    shift8(zc + lane * 8, first, P.rw_mu + lane * 8, z);
    store8h(Rb + (size_t)t * 512 + lane * 8, z);
    shift8(zc + 512 + lane * 8, first, P.rw_mu + 512 + lane * 8, z);
    store8h(Kb + (size_t)t * 512 + lane * 8, z);
    {
      float4 k0 = *(const float4*)(P.rw_k_k + lane * 8), k1 = *(const float4*)(P.rw_k_k + lane * 8 + 4);
      float kk[8] = {z[0] * k0.x, z[1] * k0.y, z[2] * k0.z, z[3] * k0.w, z[4] * k1.x, z[5] * k1.y, z[6] * k1.z, z[7] * k1.w};
      float ss = 0.f;
#pragma unroll
      for (int e = 0; e < 8; ++e) ss += kk[e] * kk[e];
      ss = sum8(ss);
      float inv = -1.f / fmaxf(sqrtf(ss), 1e-12f);
#pragma unroll
      for (int e = 0; e < 8; ++e) kk[e] *= inv;
      store8h(ALb + (size_t)t * 512 + lane * 8, kk);
    }
    shift8(zc + 1024 + lane * 8, first, P.rw_mu + 1024 + lane * 8, z);
    store8h(Vb + (size_t)t * 512 + lane * 8, z);
    if (lane < 32) {
      shift8(zc + 1536 + lane * 8, first, P.rw_mu + 1536 + lane * 8, z);
      if (lane < 8) { for (int e = 0; e < 8; ++e) z[e] = tanhf(z[e]); }
      else if (lane >= 16) { for (int e = 0; e < 8; ++e) z[e] = sigmoidf_(z[e]); }
      u32x4 o = {pack2(z[0], z[1]), pack2(z[2], z[3]), pack2(z[4], z[5]), pack2(z[6], z[7])};
      *(u32x4*)(L16 + (size_t)t * 256 + lane * 8) = o;
    }
  }
}

DI void phase_lora(const Params& P, char* smem) {
  u16* sW = (u16*)smem; u16* sX = sW + 128 * LDS_LD;
  char* ws = P.ws;
  const u16* WlT = (const u16*)(ws + OFF_WLT); const u16* L16 = (const u16*)(ws + OFF_L16);
  u16* Kb = (u16*)P.out + (size_t)T_ * 512; const u16* ALb = (const u16*)(ws + OFF_AL);
  u16* BEb = (u16*)(ws + OFF_BE); float* DDb = (float*)(ws + OFF_DD); u16* G16 = (u16*)(ws + OFF_G16);
  const int lane = threadIdx.x & 63, wave = threadIdx.x >> 6, wn = wave >> 1, wm = wave & 1, r = lane & 31, h = lane >> 5;
  constexpr int NT = 12, MT = 256;
  for (int tile = blockIdx.x; tile < NT * MT; tile += gridDim.x) {
    int mt = tile / NT, nt = tile % NT;
    f32x16 acc[2][2]; zero_acc(acc);
    gemm_tile(acc, WlT + (size_t)nt * 128 * 256, 256, L16 + (size_t)mt * 128 * 256, 256, 256, sW, sX);
#pragma unroll
    for (int ai = 0; ai < 2; ++ai)
#pragma unroll
      for (int bi = 0; bi < 2; ++bi) {
        const int nb = nt * 128 + wn * 64 + ai * 32;
        const size_t m = mt * 128 + wm * 64 + bi * 32 + r;
        const f32x16 v = acc[ai][bi];
#pragma unroll
        for (int q = 0; q < 4; ++q) {
          const int ch = (nb & 511) + 8 * q + 4 * h;
          float a4[4] = {v[4 * q], v[4 * q + 1], v[4 * q + 2], v[4 * q + 3]};
          if (nb < 512) {
            float4 w0 = *(const float4*)(P.rw_w0 + ch);
            float ww[4] = {w0.x, w0.y, w0.z, w0.w}, dd[4];
#pragma unroll
            for (int e = 0; e < 4; ++e) {
              float xx = -(ww[e] + a4[e]);
              float sp = fmaxf(xx, 0.f) + log1pf(__expf(-fabsf(xx)));
              float w = -sp - 0.5f;
              dd[e] = __expf(-__expf(w));
            }
            *(float4*)(DDb + m * 512 + ch) = make_float4(dd[0], dd[1], dd[2], dd[3]);
          } else if (nb < 1024) {
            float4 a0 = *(const float4*)(P.rw_a0 + ch), ka = *(const float4*)(P.rw_k_a + ch);
            const u32x2 kvp = *(const u32x2*)(Kb + m * 512 + ch), alp = *(const u32x2*)(ALb + m * 512 + ch);
            const float kv[4] = {bflo(kvp.x), bfhi(kvp.x), bflo(kvp.y), bfhi(kvp.y)}, al[4] = {bflo(alp.x), bfhi(alp.x), bflo(alp.y), bfhi(alp.y)};
            float aa[4] = {sigmoidf_(a0.x + a4[0]), sigmoidf_(a0.y + a4[1]), sigmoidf_(a0.z + a4[2]), sigmoidf_(a0.w + a4[3])};
            u32x2 bo = {pack2(-al[0] * aa[0], -al[1] * aa[1]), pack2(-al[2] * aa[2], -al[3] * aa[3])};
            *(u32x2*)(BEb + m * 512 + ch) = bo;
            u32x2 ko = {pack2(kv[0] * (1.f + (aa[0] - 1.f) * ka.x), kv[1] * (1.f + (aa[1] - 1.f) * ka.y)),
                        pack2(kv[2] * (1.f + (aa[2] - 1.f) * ka.z), kv[3] * (1.f + (aa[3] - 1.f) * ka.w))};
            *(u32x2*)(Kb + m * 512 + ch) = ko;
          } else {
            u32x2 pk = {pack2(a4[0], a4[1]), pack2(a4[2], a4[3])};
            *(u32x2*)(G16 + m * 512 + ch) = pk;
          }
        }
      }
  }
}

constexpr int SC_TB = 8;
constexpr int SC_WLDS = 6 * SC_TB * 64;
template <int MODE>
DI void scan_chunk(const Params& P, int bh, int c, int lane, float* lds) {
  char* ws = P.ws;
  const int b = bh >> 3, h = bh & 7;
  const size_t tok0 = (size_t)b * S_ + (size_t)c * CH_L;
  const size_t base = tok0 * 512 + h * 64;
  const u16* arh[6] = {(const u16*)(ws + OFF_AL) + base, (const u16*)(ws + OFF_BE) + base, nullptr,
                       (const u16*)P.out + (size_t)T_ * 512 + base, (const u16*)P.out + base, (const u16*)(ws + OFF_V) + base};
  const float* ard = (const float*)(ws + OFF_DD) + base;
  float* PM = (float*)(ws + OFF_PM); float* HM = (float*)(ws + OFF_HM);
  f32x2 SA[32], SB[32];
  if (MODE == 0) {
#pragma unroll
    for (int p = 0; p < 32; ++p) { SA[p].x = (2 * p == lane) ? 1.f : 0.f; SA[p].y = (2 * p + 1 == lane) ? 1.f : 0.f; SB[p].x = 0.f; SB[p].y = 0.f; }
  } else if (c == 0) {
#pragma unroll
    for (int p = 0; p < 32; ++p) { SA[p].x = 0.f; SA[p].y = 0.f; }
  } else {
    const float4* src = (const float4*)(HM + ((size_t)(bh * CH_C + c - 1) * 64 + lane) * 64);
#pragma unroll
    for (int q = 0; q < 16; ++q) { float4 v = src[q]; SA[2 * q].x = v.x; SA[2 * q].y = v.y; SA[2 * q + 1].x = v.z; SA[2 * q + 1].y = v.w; }
  }
  float lng = 0.f, lnb = 0.f, rk = 0.f;
  const u16* G16 = (const u16*)(ws + OFF_G16) + base;
  u16* CAT = (u16*)(ws + OFF_ACT) + tok0 * 1024 + 512 + h * 64;
  if (MODE == 2) { lng = P.rw_ln_g[h * 64 + lane]; lnb = P.rw_ln_b[h * 64 + lane]; rk = P.rw_r_k[h * 64 + lane]; }
  const int st_t = lane >> 4, st_q = (lane & 15) * 4;
#pragma unroll 1
  for (int tb = 0; tb < CH_L / SC_TB; ++tb) {
    {
      u32x4 ph[6]; f32x4 pd[2];
#pragma unroll
      for (int a = 0; a < 6; ++a) {
        if (a == 2 || (MODE == 0 && a == 4)) continue;
        ph[a] = *(const u32x4*)(arh[a] + (size_t)(tb * SC_TB + (lane >> 3)) * 512 + (lane & 7) * 8);
      }
#pragma unroll
      for (int f = 0; f < 2; ++f) pd[f] = *(const f32x4*)(ard + (size_t)(tb * SC_TB + f * 4 + st_t) * 512 + st_q);
#pragma unroll
      for (int a = 0; a < 6; ++a) {
        if (a == 2 || (MODE == 0 && a == 4)) continue;
        float* dst = lds + (a * SC_TB + (lane >> 3)) * 64 + (lane & 7) * 8;
        f32x4 lo = {bflo(ph[a].x), bfhi(ph[a].x), bflo(ph[a].y), bfhi(ph[a].y)}, hi = {bflo(ph[a].z), bfhi(ph[a].z), bflo(ph[a].w), bfhi(ph[a].w)};
        *(f32x4*)dst = lo; *(f32x4*)(dst + 4) = hi;
      }
#pragma unroll
      for (int f = 0; f < 2; ++f) *(f32x4*)(lds + ((4 + f) * 64 + lane) * 4) = pd[f];
    }
#pragma unroll 1
    for (int t = 0; t < SC_TB; ++t) {
      const float* la = lds + t * 64;
      const float vi = la[5 * SC_TB * 64 + lane];
      float gbits = 0.f;
      if (MODE == 2) gbits = __uint_as_float((u32)G16[(size_t)(tb * SC_TB + t) * 512 + lane] << 16);
      f32x2 sa2 = {0.f, 0.f}, sb2 = {0.f, 0.f};
#pragma unroll
      for (int q = 0; q < 16; ++q) {
        if ((q & 3) == 0) asm volatile("" ::: "memory");
        const f32x4 al = *(const f32x4*)(la + 4 * q);
        const f32x2 al0 = {al.x, al.y}, al1 = {al.z, al.w};
        sa2 = SA[2 * q] * al0 + sa2; sa2 = SA[2 * q + 1] * al1 + sa2;
        if (MODE == 0) { sb2 = SB[2 * q] * al0 + sb2; sb2 = SB[2 * q + 1] * al1 + sb2; }
      }
      const float sa = sa2.x + sa2.y, sb = sb2.x + sb2.y;
      const f32x2 sav = {sa, sa}, sbv = {sb, sb}, viv = {vi, vi};
      f32x2 y2 = {0.f, 0.f};
#pragma unroll
      for (int q = 0; q < 16; ++q) {
        if ((q & 1) == 0) asm volatile("" ::: "memory");
        const f32x4 be = *(const f32x4*)(la + 1 * SC_TB * 64 + 4 * q);
        const f32x4 dd = *(const f32x4*)(la + 2 * SC_TB * 64 + 4 * q);
        const f32x4 kk = *(const f32x4*)(la + 3 * SC_TB * 64 + 4 * q);
        const f32x2 be0 = {be.x, be.y}, be1 = {be.z, be.w}, dd0 = {dd.x, dd.y}, dd1 = {dd.z, dd.w}, kk0 = {kk.x, kk.y}, kk1 = {kk.z, kk.w};
        if (MODE == 0) {
          SA[2 * q] = SA[2 * q] * dd0 + sav * be0; SA[2 * q + 1] = SA[2 * q + 1] * dd1 + sav * be1;
          SB[2 * q] = SB[2 * q] * dd0 + (viv * kk0 + sbv * be0); SB[2 * q + 1] = SB[2 * q + 1] * dd1 + (viv * kk1 + sbv * be1);
        } else {
          const f32x4 rr = *(const f32x4*)(la + 4 * SC_TB * 64 + 4 * q);
          const f32x2 rr0 = {rr.x, rr.y}, rr1 = {rr.z, rr.w};
          SA[2 * q] = SA[2 * q] * dd0 + (viv * kk0 + sav * be0); SA[2 * q + 1] = SA[2 * q + 1] * dd1 + (viv * kk1 + sav * be1);
          y2 = SA[2 * q] * rr0 + y2; y2 = SA[2 * q + 1] * rr1 + y2;
        }
      }
      if (MODE == 2) {
        const float y = y2.x + y2.y;
        const float rj = la[4 * SC_TB * 64 + lane], kj = la[3 * SC_TB * 64 + lane];
        const float mean = wave_sum(y) * (1.f / 64.f);
        const float dv = y - mean;
        const float var = wave_sum(dv * dv) * (1.f / 64.f);
        const float bonus = wave_sum(rj * kj * rk);
        float yn = dv * rsqrtf(var + 64e-5f) * lng + lnb;
        yn += bonus * vi;
        CAT[(size_t)(tb * SC_TB + t) * 1024 + lane] = f2bf(yn * gbits);
      }
    }
  }
  if (MODE == 0) {
    float4* dp = (float4*)(PM + ((size_t)(bh * CH_C + c) * 64 + lane) * 64);
    float4* dh = (float4*)(HM + ((size_t)(bh * CH_C + c) * 64 + lane) * 64);
#pragma unroll
    for (int q = 0; q < 16; ++q) {
      dp[q] = make_float4(SA[2 * q].x, SA[2 * q].y, SA[2 * q + 1].x, SA[2 * q + 1].y);
      dh[q] = make_float4(SB[2 * q].x, SB[2 * q].y, SB[2 * q + 1].x, SB[2 * q + 1].y);
    }
  }
}
DI void phase_scan1(const Params& P, char* smem) {
  const int lane = threadIdx.x & 63;
  const int wave = __builtin_amdgcn_readfirstlane((int)(threadIdx.x >> 6));
  float* lds = (float*)smem + wave * SC_WLDS;
  const int nitems = 32 * (CH_C - 1);
  for (int it = blockIdx.x * 4 + wave; it < nitems; it += gridDim.x * 4) scan_chunk<0>(P, it / (CH_C - 1), it % (CH_C - 1), lane, lds);
}
DI void phase_scan2(const Params& P, char* smem) {
  constexpr int SLD = 68;
  float* sA = (float*)smem;
  char* ws = P.ws;
  float* HM = (float*)(ws + OFF_HM); const float* PM = (const float*)(ws + OFF_PM);
  const int lane = threadIdx.x & 63, wave = threadIdx.x >> 6, ib = wave >> 1, jb = wave & 1, r = lane & 31, g = lane >> 5;
  for (int bh = blockIdx.x; bh < 32; bh += gridDim.x) {
    float av[32];
    {
      const float* s0 = HM + ((size_t)(bh * CH_C) * 64 + 32 * ib + r) * 64 + g;
#pragma unroll
      for (int kk = 0; kk < 32; ++kk) av[kk] = s0[2 * kk];
    }
#pragma unroll 1
    for (int c = 1; c <= CH_C - 2; ++c) {
      const float* pb = PM + ((size_t)(bh * CH_C + c) * 64 + g) * 64 + 32 * jb + r;
      float* hb = HM + ((size_t)(bh * CH_C + c) * 64 + 32 * ib + 4 * g) * 64 + 32 * jb + r;
      f32x16 acc;
#pragma unroll
      for (int q = 0; q < 16; ++q) acc[q] = hb[(size_t)((q & 3) + 8 * (q >> 2)) * 64];
      float bv[32];
#pragma unroll
      for (int kk = 0; kk < 32; ++kk) bv[kk] = pb[(size_t)(2 * kk) * 64];
#pragma unroll
      for (int kk = 0; kk < 32; ++kk) acc = __builtin_amdgcn_mfma_f32_32x32x2f32(av[kk], bv[kk], acc, 0, 0, 0);
      const int j = 32 * jb + r;
      __syncthreads();
#pragma unroll
      for (int q = 0; q < 16; ++q) {
        const int il = (q & 3) + 8 * (q >> 2) + 4 * g;
        hb[(size_t)((q & 3) + 8 * (q >> 2)) * 64] = acc[q];
        sA[(32 * ib + il) * SLD + (j & 1) * 32 + (j >> 1)] = acc[q];
      }
      __syncthreads();
#pragma unroll
      for (int k4 = 0; k4 < 8; ++k4) {
        const float4 v = *(const float4*)(sA + (32 * ib + r) * SLD + g * 32 + 4 * k4);
        av[4 * k4] = v.x; av[4 * k4 + 1] = v.y; av[4 * k4 + 2] = v.z; av[4 * k4 + 3] = v.w;
      }
    }
  }
}
DI void phase_scan3(const Params& P, char* smem) {
  const int lane = threadIdx.x & 63;
  const int wave = __builtin_amdgcn_readfirstlane((int)(threadIdx.x >> 6));
  float* lds = (float*)smem + wave * SC_WLDS;
  const int nitems = 32 * CH_C;
  for (int it = blockIdx.x * 4 + wave; it < nitems; it += gridDim.x * 4) scan_chunk<2>(P, it / CH_C, it % CH_C, lane, lds);
}

DI void phase_outproj(const Params& P, char* smem) {
  u16* sW = (u16*)smem; u16* sX = sW + 128 * LDS_LD;
  char* ws = P.ws;
  const u16* Wt = (const u16*)(ws + OFF_WOUTT); const u16* CAT = (const u16*)(ws + OFF_ACT);
  const int lane = threadIdx.x & 63, wave = threadIdx.x >> 6, wn = wave >> 1, wm = wave & 1, r = lane & 31, h = lane >> 5;
  constexpr int NT = 8, MT = 256;
  for (int tile = blockIdx.x; tile < NT * MT; tile += gridDim.x) {
    int mt = tile / NT, nt = tile % NT;
    f32x16 acc[2][2]; zero_acc(acc);
    gemm_tile(acc, Wt + (size_t)nt * 128 * 1024, 1024, CAT + (size_t)mt * 128 * 1024, 1024, 1024, sW, sX);
#pragma unroll
    for (int ai = 0; ai < 2; ++ai)
#pragma unroll
      for (int bi = 0; bi < 2; ++bi) {
        const int nb = nt * 128 + wn * 64 + ai * 32;
        const size_t m = mt * 128 + wm * 64 + bi * 32 + r;
#pragma unroll
        for (int q = 0; q < 4; ++q) {
          const int n = nb + 8 * q + 4 * h;
          float4 xv = *(const float4*)(P.x + m * 1024 + n);
          *(float4*)(P.out + m * 1024 + n) = make_float4(xv.x + acc[ai][bi][4 * q], xv.y + acc[ai][bi][4 * q + 1], xv.z + acc[ai][bi][4 * q + 2], xv.w + acc[ai][bi][4 * q + 3]);
        }
      }
  }
}

DI void phase_qproj(const Params& P, char* smem, int half) {
  u16* sW = (u16*)smem; u16* sX = sW + 128 * LDS_LD;
  char* ws = P.ws;
  const u16* Wt = (const u16*)(ws + OFF_WQT); const u16* A = (const u16*)(ws + OFF_ACT); u16* Q16 = (u16*)(ws + OFF_Q16);
  const int lane = threadIdx.x & 63, wave = threadIdx.x >> 6, wn = wave >> 1, wm = wave & 1, r = lane & 31, h = lane >> 5;
  constexpr int NT = 16, MT = 128;
  for (int tile = blockIdx.x; tile < NT * MT; tile += gridDim.x) {
    int mt = tile / NT, nt = tile % NT;
    f32x16 acc[2][2]; zero_acc(acc);
    gemm_tile(acc, Wt + (size_t)nt * 128 * 1024, 1024, A + (size_t)(half * 128 + mt) * 128 * 1024, 1024, 1024, sW, sX);
#pragma unroll
    for (int ai = 0; ai < 2; ++ai)
#pragma unroll
      for (int bi = 0; bi < 2; ++bi) {
        const int nb = nt * 128 + wn * 64 + ai * 32;
        const size_t m = mt * 128 + wm * 64 + bi * 32 + r;
#pragma unroll
        for (int q = 0; q < 4; ++q) {
          u32x2 pk = {pack2(acc[ai][bi][4 * q], acc[ai][bi][4 * q + 1]), pack2(acc[ai][bi][4 * q + 2], acc[ai][bi][4 * q + 3])};
          *(u32x2*)(Q16 + m * 2048 + nb + 8 * q + 4 * h) = pk;
        }
      }
  }
}
DI void phase_scores(const Params& P, char* smem) {
  u16* sW = (u16*)smem; u16* sX = sW + 128 * LDS_LD;
  char* ws = P.ws;
  const u16* SK = (const u16*)(ws + OFF_SUBK); const u16* Q16 = (const u16*)(ws + OFF_Q16); float* ST = (float*)(ws + OFF_ST);
  const int lane = threadIdx.x & 63, wave = threadIdx.x >> 6, wn = wave >> 1, wm = wave & 1, r = lane & 31, h = lane >> 5;
  for (int tile = blockIdx.x; tile < 16 * 128; tile += gridDim.x) {
    int mt = tile >> 4, hp = tile & 15;
    f32x16 acc[2][2]; zero_acc(acc);
    gemm_tile(acc, SK + (size_t)hp * 128 * 128, 128, Q16 + (size_t)mt * 128 * 2048 + hp * 128, 2048, 128, sW, sX);
#pragma unroll
    for (int ai = 0; ai < 2; ++ai)
#pragma unroll
      for (int bi = 0; bi < 2; ++bi) {
        const int nb = wn * 64 + ai * 32;
        const size_t m = mt * 128 + wm * 64 + bi * 32 + r;
#pragma unroll
        for (int i = 0; i < 16; ++i) ST[((size_t)(hp * 128 + nb + crow(i, h))) * TH_ + m] = acc[ai][bi][i];
      }
  }
}
DI u32 ford(float f) { u32 u = __float_as_uint(f); return u ^ ((u32)((int)u >> 31) | 0x80000000u); }
DI float funord(u32 k) { u32 u = (k & 0x80000000u) ? (k ^ 0x80000000u) : ~k; return __uint_as_float(u); }
DI void ins16(u32 (&L)[16], u32 x) {
#pragma unroll
  for (int k = 0; k < 16; ++k) { u32 hi = max(L[k], x); x = min(L[k], x); L[k] = hi; }
}
DI void phase_topk(const Params& P, int half) {
  char* ws = P.ws;
  const float* ST = (const float*)(ws + OFF_ST); int* IDX = (int*)(ws + OFF_IDX); float* GATE = (float*)(ws + OFF_GATE);
  const int lane = threadIdx.x & 63, wave = threadIdx.x >> 6;
  for (int it = blockIdx.x * 4 + wave; it < (TH_ / 64) * 8; it += gridDim.x * 4) {
    const int hd = it & 7, tl = (it >> 3) * 64 + lane, t = half * TH_ + tl;
    u32 L1[16], L2[16];
#pragma unroll
    for (int k = 0; k < 16; ++k) { L1[k] = 0u; L2[k] = 0u; }
    const float* s1 = ST + ((size_t)(hd * 2) * 128) * TH_ + tl;
    const float* s2 = ST + ((size_t)(hd * 2 + 1) * 128) * TH_ + tl;
#pragma unroll 8
    for (int n = 0; n < 128; ++n) {
      ins16(L1, (ford(s1[(size_t)n * TH_]) & ~127u) | (u32)(127 - n));
      ins16(L2, (ford(s2[(size_t)n * TH_]) & ~127u) | (u32)(127 - n));
    }
    float v1[16], v2[16];
#pragma unroll
    for (int k = 0; k < 16; ++k) { v1[k] = funord(L1[k] & ~127u); v2[k] = funord(L2[k] & ~127u); }
    u32 C[16];
#pragma unroll
    for (int k = 0; k < 16; ++k) C[k] = 0u;
#pragma unroll
    for (int a = 0; a < 16; ++a)
#pragma unroll
      for (int bb = 0; bb < 16; ++bb)
        if ((a + 1) * (bb + 1) <= 16) ins16(C, (ford(v1[a] + v2[bb]) & ~255u) | (u32)(255 - (a * 16 + bb)));
    float best[16]; float den = 0.f;
    const float m0 = funord(C[0] & ~255u);
#pragma unroll
    for (int k = 0; k < 16; ++k) { best[k] = __expf(funord(C[k] & ~255u) - m0); den += best[k]; }
    const float rden = 1.f / den;
#pragma unroll
    for (int k4 = 0; k4 < 4; ++k4) {
      int id[4];
#pragma unroll
      for (int u = 0; u < 4; ++u) {
        const int k = k4 * 4 + u;
        const int ab = 255 - (int)(C[k] & 255u), a = ab >> 4, bb = ab & 15;
        u32 e1 = 0, e2 = 0;
#pragma unroll
        for (int q = 0; q < 16; ++q) { e1 = (a == q) ? L1[q] : e1; e2 = (bb == q) ? L2[q] : e2; }
        id[u] = (127 - (int)(e1 & 127u)) * 128 + (127 - (int)(e2 & 127u));
      }
      *(int4*)(IDX + (size_t)t * 128 + hd * 16 + k4 * 4) = make_int4(id[0], id[1], id[2], id[3]);
      *(float4*)(GATE + (size_t)t * 128 + hd * 16 + k4 * 4) = make_float4(best[k4 * 4] * rden, best[k4 * 4 + 1] * rden, best[k4 * 4 + 2] * rden, best[k4 * 4 + 3] * rden);
    }
  }
}
DI float gelu_(float x) { return 0.5f * x * (1.f + erff(x * 0.70710678118654752f)); }
DI void fp8x16_to_f32(u32x4 v, float (&f)[16]) {
  const u32 w[4] = {v.x, v.y, v.z, v.w};
#pragma unroll
  for (int k = 0; k < 4; ++k) {
    f32x2 lo = __builtin_amdgcn_cvt_pk_f32_fp8((int)w[k], false), hi = __builtin_amdgcn_cvt_pk_f32_fp8((int)w[k], true);
    f[4 * k] = lo.x; f[4 * k + 1] = lo.y; f[4 * k + 2] = hi.x; f[4 * k + 3] = hi.y;
  }
}
DI void phase_gather(const Params& P) {
  char* ws = P.ws;
  const int* IDX = (const int*)(ws + OFF_IDX); const float* GATE = (const float*)(ws + OFF_GATE);
  const unsigned char* PU = (const unsigned char*)(ws + OFF_PU16); const unsigned char* PV = (const unsigned char*)(ws + OFF_PV16);
  u16* ACT = (u16*)(ws + OFF_ACT);
  const int lane = threadIdx.x & 63, wave = threadIdx.x >> 6;
  for (int t = blockIdx.x * 4 + wave; t < T_; t += gridDim.x * 4) {
    const u16* xr = ACT + (size_t)t * 1024 + lane * 16;
    float xf[16];
    {
      const u32x4 x0 = *(const u32x4*)xr, x1 = *(const u32x4*)(xr + 8);
      xf[0] = bflo(x0.x); xf[1] = bfhi(x0.x); xf[2] = bflo(x0.y); xf[3] = bfhi(x0.y); xf[4] = bflo(x0.z); xf[5] = bfhi(x0.z); xf[6] = bflo(x0.w); xf[7] = bfhi(x0.w);
      xf[8] = bflo(x1.x); xf[9] = bfhi(x1.x); xf[10] = bflo(x1.y); xf[11] = bfhi(x1.y); xf[12] = bflo(x1.z); xf[13] = bfhi(x1.z); xf[14] = bflo(x1.w); xf[15] = bfhi(x1.w);
    }
    int id[2]; float gt[2];
    id[0] = IDX[(size_t)t * 128 + lane]; id[1] = IDX[(size_t)t * 128 + 64 + lane];
    gt[0] = GATE[(size_t)t * 128 + lane]; gt[1] = GATE[(size_t)t * 128 + 64 + lane];
    float acc[16];
#pragma unroll
    for (int k = 0; k < 16; ++k) acc[k] = 0.f;
#pragma unroll
    for (int hf = 0; hf < 2; ++hf) {
#pragma unroll 1
      for (int hq = 0; hq < 4; ++hq) {
        u32x4 rec[16];
#pragma unroll
        for (int j = 0; j < 16; ++j) {
          const int row = __builtin_amdgcn_readlane(id[hf], hq * 16 + j);
          rec[j] = *(const u32x4*)(PU + (size_t)row * 1024 + lane * 16);
        }
        float dsel = 0.f;
        const int li = lane & 15;
#pragma unroll
        for (int j = 0; j < 16; ++j) {
          float uf[16]; fp4x8_to_f32(rec[j].x, uf); fp4x8_to_f32(rec[j].y, uf + 8);
          float p0 = 0.f, p1 = 0.f;
#pragma unroll
          for (int k = 0; k < 16; k += 2) { p0 = fmaf(uf[k], xf[k], p0); p1 = fmaf(uf[k + 1], xf[k + 1], p1); }
          float rs = sum8(p0 + p1); rs += dppf<0x140>(rs);
          dsel = (li == j) ? rs : dsel;
        }
        dsel += __shfl_xor(dsel, 16);
        dsel += __shfl_xor(dsel, 32);
        const float wsel = 0.1f * gt[hf] * gelu_(dsel * 0.015625f);
#pragma unroll
        for (int j = 0; j < 16; ++j) {
          const float w = rlf(wsel, hq * 16 + j);
          float vf[16]; fp4x8_to_f32(rec[j].z, vf); fp4x8_to_f32(rec[j].w, vf + 8);
#pragma unroll
          for (int k = 0; k < 16; ++k) acc[k] = fmaf(w, vf[k], acc[k]);
        }
      }
    }
    float* hr = P.out + (size_t)t * 1024 + lane * 16;
    float ss = 0.f;
#pragma unroll
    for (int q = 0; q < 4; ++q) {
      float4 hv = *(const float4*)(hr + 4 * q);
      hv.x += acc[4 * q]; hv.y += acc[4 * q + 1]; hv.z += acc[4 * q + 2]; hv.w += acc[4 * q + 3];
      *(float4*)(hr + 4 * q) = hv;
      acc[4 * q] = hv.x; acc[4 * q + 1] = hv.y; acc[4 * q + 2] = hv.z; acc[4 * q + 3] = hv.w;
      ss += hv.x * hv.x + hv.y * hv.y + hv.z * hv.z + hv.w * hv.w;
    }
    ss = wave_sum(ss);
    const float rs = rsqrtf(ss * (1.f / 1024.f) + 1e-6f);
    const float* g = P.norm_ple_g + lane * 16;
    u32 o[8];
#pragma unroll
    for (int q = 0; q < 4; ++q) {
      float4 gg = *(const float4*)(g + 4 * q);
      o[2 * q] = pack2(acc[4 * q] * rs * gg.x, acc[4 * q + 1] * rs * gg.y); o[2 * q + 1] = pack2(acc[4 * q + 2] * rs * gg.z, acc[4 * q + 3] * rs * gg.w);
    }
    u32x4 o0 = {o[0], o[1], o[2], o[3]}, o1 = {o[4], o[5], o[6], o[7]};
    *(u32x4*)(ACT + (size_t)t * 1024 + lane * 16) = o0; *(u32x4*)(ACT + (size_t)t * 1024 + lane * 16 + 8) = o1;
  }
}
DI void phase_ple(const Params& P, char* smem) {
  u16* sW = (u16*)smem; u16* sX = sW + 128 * LDS_LD;
  char* ws = P.ws;
  const u16* WgT = (const u16*)(ws + OFF_WGT); const u16* WpT = (const u16*)(ws + OFF_WPT);
  const u16* A = (const u16*)(ws + OFF_ACT); const u16* P16 = (const u16*)(ws + OFF_P16);
  const int lane = threadIdx.x & 63, wave = threadIdx.x >> 6, wn = wave >> 1, wm = wave & 1, r = lane & 31, h = lane >> 5;
  constexpr int NT = 8, MT = 256;
  for (int tile = blockIdx.x; tile < NT * MT; tile += gridDim.x) {
    int mt = tile / NT, nt = tile % NT;
    f32x16 acc[2][2], acc2[2][2]; zero_acc(acc); zero_acc(acc2);
    gemm_tile(acc, WgT + (size_t)nt * 128 * 1024, 1024, A + (size_t)mt * 128 * 1024, 1024, 1024, sW, sX);
    gemm_tile(acc2, WpT + (size_t)nt * 128 * 256, 256, P16 + (size_t)mt * 128 * 256, 256, 256, sW, sX);
#pragma unroll
    for (int ai = 0; ai < 2; ++ai)
#pragma unroll
      for (int bi = 0; bi < 2; ++bi) {
        const int nb = nt * 128 + wn * 64 + ai * 32;
        const size_t m = mt * 128 + wm * 64 + bi * 32 + r;
#pragma unroll
        for (int q = 0; q < 4; ++q) {
          const int n = nb + 8 * q + 4 * h;
          float4 hv = *(const float4*)(P.out + m * 1024 + n);
          hv.x += sigmoidf_(acc[ai][bi][4 * q]) * acc2[ai][bi][4 * q];
          hv.y += sigmoidf_(acc[ai][bi][4 * q + 1]) * acc2[ai][bi][4 * q + 1];
          hv.z += sigmoidf_(acc[ai][bi][4 * q + 2]) * acc2[ai][bi][4 * q + 2];
          hv.w += sigmoidf_(acc[ai][bi][4 * q + 3]) * acc2[ai][bi][4 * q + 3];
          *(float4*)(P.out + m * 1024 + n) = hv;
        }
      }
  }
}
DI void phase_final(const Params& P) {
  const int lane = threadIdx.x & 63, wave = threadIdx.x >> 6;
  for (int t = blockIdx.x * 4 + wave; t < T_; t += gridDim.x * 4) {
    float4* row = (float4*)(P.out + (size_t)t * 1024);
    float4 v[4]; float ss = 0.f;
#pragma unroll
    for (int i = 0; i < 4; ++i) { v[i] = row[lane + 64 * i]; ss += v[i].x * v[i].x + v[i].y * v[i].y + v[i].z * v[i].z + v[i].w * v[i].w; }
    ss = wave_sum(ss);
    const float rs = rsqrtf(ss * (1.f / 1024.f) + 1e-6f);
#pragma unroll
    for (int i = 0; i < 4; ++i) {
      float4 g = ((const float4*)P.norm_final_g)[lane + 64 * i];
      row[lane + 64 * i] = make_float4(v[i].x * rs * g.x, v[i].y * rs * g.y, v[i].z * rs * g.z, v[i].w * rs * g.w);
    }
  }
}

#ifndef PH_MASK
#define PH_MASK 0xFFFFFFFFu
#endif
#define PH(n) if ((PH_MASK >> (n)) & 1u)
#define XB_TMO      128
#define XB_XCNT(j)  (256  + 64 * (j))
#define XB_XSUB(j)  (1280 + 64 * (j))
#define XB_XGEN(j)  (2304 + 64 * (j))
#define XB_TOP      3328
#define XB_TOPGEN   3392
#define XCD_BAR_WORDS 3456
#define XB_SPIN_CAP (1u << 18)
#define LAS __attribute__((address_space(3)))

__device__ __forceinline__ unsigned xb_ld(unsigned* p)              { return __hip_atomic_load(p, __ATOMIC_RELAXED, __HIP_MEMORY_SCOPE_AGENT); }
__device__ __forceinline__ unsigned xb_add(unsigned* p, unsigned v) { return __hip_atomic_fetch_add(p, v, __ATOMIC_RELAXED, __HIP_MEMORY_SCOPE_AGENT); }
__device__ __forceinline__ unsigned xb_xcc_id() { return (unsigned)__builtin_amdgcn_s_getreg((3 << 11) | 20) & 0xFu; }
#define XB_SPIN(cond, bar) do { unsigned _sp = 0; while (cond) { __builtin_amdgcn_s_sleep(1); \
    if ((++_sp & 255u) == 0u) { if (xb_ld(&(bar)[XB_TMO])) break; if (_sp > XB_SPIN_CAP) { atomicAdd(&(bar)[XB_TMO], 1u); break; } } } } while (0)

struct XcdBarrier {
    unsigned* bar; unsigned x;
    volatile LAS unsigned* st;
};

__device__ __forceinline__ XcdBarrier xcd_barrier_post(unsigned* bar, volatile LAS unsigned* st) {
    XcdBarrier b; b.bar = bar; b.x = xb_xcc_id(); b.st = st;
    if (threadIdx.x == 0) (void)xb_add(&bar[XB_XCNT(b.x)], 1u);
    return b;
}
__device__ __forceinline__ void xcd_barrier_complete(unsigned* bar, unsigned x, unsigned& nloc, unsigned& nx) {
    const unsigned G = gridDim.x * gridDim.y * gridDim.z;
    unsigned sum, cnt, mine, sp = 0u;
    for (;;) {
        sum = 0u; cnt = 0u; mine = 0u;
#pragma unroll
        for (unsigned j = 0; j < 16; ++j) { const unsigned c = xb_ld(&bar[XB_XCNT(j)]); sum += c; cnt += (c > 0u) ? 1u : 0u; mine = (j == x) ? c : mine; }
        if (sum == G) break;
        __builtin_amdgcn_s_sleep(1);
        if ((++sp & 255u) == 0u) { if (xb_ld(&bar[XB_TMO])) break; if (sp > XB_SPIN_CAP) { atomicAdd(&bar[XB_TMO], 1u); break; } }
    }
    nloc = mine > 0u ? mine : 1u; nx = cnt > 0u ? cnt : 1u;
}

__device__ __forceinline__ void xcd_barrier(const XcdBarrier& b) {
    asm volatile("s_waitcnt vmcnt(0)" ::: "memory");
    __syncthreads();
    if (threadIdx.x == 0) {
        unsigned* bar = b.bar;
        __builtin_amdgcn_s_waitcnt(0);
        unsigned nloc = b.st[0], nx = b.st[1];
        if (nloc == 0u) { xcd_barrier_complete(bar, b.x, nloc, nx); b.st[0] = nloc; b.st[1] = nx; }
        const unsigned old = xb_add(&bar[XB_XSUB(b.x)], 1u);
        const unsigned gen = old / nloc;
        if (old + 1u == (gen + 1u) * nloc) {
            __builtin_amdgcn_fence(__ATOMIC_RELEASE, "agent");
            asm volatile("s_waitcnt vmcnt(0)" ::: "memory");
            const unsigned og = xb_add(&bar[XB_TOP], 1u);
            const unsigned tg = og / nx;
            if (og + 1u == (tg + 1u) * nx) xb_add(&bar[XB_TOPGEN], 1u);
            else XB_SPIN(xb_ld(&bar[XB_TOPGEN]) == tg, bar);
            __builtin_amdgcn_fence(__ATOMIC_ACQUIRE, "agent");
            xb_add(&bar[XB_XGEN(b.x)], 1u);
            asm volatile("s_waitcnt vmcnt(0)" ::: "memory");
        } else {
            XB_SPIN(xb_ld(&bar[XB_XGEN(b.x)]) == gen, bar);
            __builtin_amdgcn_fence(__ATOMIC_ACQUIRE, "agent");
            asm volatile("s_waitcnt vmcnt(0)" ::: "memory");
        }
    }
    __syncthreads();
}

constexpr int SMEM_BYTES = 2 * 2 * 128 * LDS_LD * 2;

__global__ void __launch_bounds__(256, 2) mega(Params P) {
  __shared__ __attribute__((aligned(16))) char smem[SMEM_BYTES];
  cg::grid_group grid = cg::this_grid();
  __shared__ __attribute__((aligned(16))) unsigned xb_st[4];
  if (threadIdx.x < 4) xb_st[threadIdx.x] = 0u;
  __syncthreads();
  XcdBarrier xb = xcd_barrier_post((unsigned*)(P.ws + OFF_CTR + 4096), (volatile LAS unsigned*)xb_st);
#define RUN(n, ...) PH(n) { if (P.ph_lo <= (n) && (n) <= P.ph_hi) { __VA_ARGS__; } } if (P.ph_lo <= (n) && (n) < P.ph_hi) { if ((n) == 0) grid.sync(); else xcd_barrier(xb); }
  RUN(0, phase_prep(P, smem))
  RUN(1, phase_gemm1(P, smem))
  RUN(2, phase_attn(P, smem); phase_rwprep(P))
  RUN(4, phase_lora(P, smem))
  RUN(5, phase_scan1(P, smem))
  RUN(6, phase_scan2(P, smem); convert_uv_fp4(P.peer_u, P.peer_v, (unsigned char*)(P.ws + OFF_PU16), 64.f, 10.f, gridDim.x > 64 ? 32 : 0))
  RUN(7, phase_scan3(P, smem))
  RUN(8, phase_outproj(P, smem); convert_flat(P.p, (u16*)(P.ws + OFF_P16), (size_t)T_ * 256))
  RUN(9, rmsnorm_rows(P.out, P.norm_ffn_g, (u16*)(P.ws + OFF_ACT)))
  RUN(10, phase_qproj(P, smem, 0))
  RUN(11, phase_scores(P, smem))
  RUN(12, phase_qproj(P, smem, 1); phase_topk(P, 0))
  RUN(14, phase_scores(P, smem))
  RUN(15, phase_topk(P, 1))
  RUN(16, phase_gather(P))
  RUN(17, phase_ple(P, smem))
  RUN(18, phase_final(P))
}

extern "C" void kernel_launch(void* const* d_in, const int* in_sizes, int n_in, void* d_out, int out_size, void* d_ws, size_t ws_size,
                              hipStream_t stream) {
  static int grid_blocks = 0;
  if (!grid_blocks) {
    int dev = 0, cus = 0, per_cu = 0;
    hipGetDevice(&dev);
    hipDeviceGetAttribute(&cus, hipDeviceAttributeMultiprocessorCount, dev);
    hipOccupancyMaxActiveBlocksPerMultiprocessor(&per_cu, mega, 256, 0);
    if (per_cu < 1) per_cu = 1;
    if (per_cu > 2) per_cu = 2;
    grid_blocks = cus * per_cu;
  }
  Params P{};
  const float* const* fi = (const float* const*)d_in;
  P.x = fi[0]; P.p = fi[1]; P.pos = (const int*)d_in[2];
  P.norm_mix_g = fi[3]; P.w_in = fi[4]; P.lam_q1 = fi[5]; P.lam_k1 = fi[6]; P.lam_q2 = fi[7]; P.lam_k2 = fi[8]; P.subln_g = fi[9];
  P.rw_mu = fi[10]; P.rw_w0 = fi[11]; P.rw_w_up = fi[12]; P.rw_a0 = fi[13]; P.rw_a_up = fi[14]; P.rw_g_up = fi[15];
  P.rw_k_k = fi[16]; P.rw_k_a = fi[17]; P.rw_r_k = fi[18]; P.rw_ln_g = fi[19]; P.rw_ln_b = fi[20];
  P.w_out = fi[21]; P.norm_ffn_g = fi[22]; P.peer_w_q = fi[23]; P.peer_sub_keys = fi[24]; P.peer_u = fi[25]; P.peer_v = fi[26];
  P.norm_ple_g = fi[27]; P.ple_gate_w = fi[28]; P.ple_proj_w = fi[29]; P.norm_final_g = fi[30];
  P.out = (float*)d_out; P.ws = (char*)d_ws;
  for (int i = 0; i < 8; ++i) P.inv_freq[i] = (float)pow(500000.0, -(double)i / 8.0);
  hipMemsetAsync((char*)d_ws + OFF_CTR, 0, 32768, stream);
#ifndef ONE_LAUNCH
  for (int ph = 0; ph < 19; ++ph) {
    P.ph_lo = ph; P.ph_hi = ph;
    hipLaunchKernelGGL(mega, dim3(grid_blocks), dim3(256), 0, stream, P);
  }
#else
  P.ph_lo = 0; P.ph_hi = 18;
  void* args[] = {&P};
  hipLaunchCooperativeKernel((void*)mega, dim3(grid_blocks), dim3(256), args, 0, stream);
#endif
}
```

```cpp
#include <hip/hip_runtime.h>
#include <hip/hip_cooperative_groups.h>
#include <stdint.h>
#include <math.h>
namespace cg = cooperative_groups;

#define DI __device__ __forceinline__
#define ONE_LAUNCH 1
typedef unsigned short u16;
typedef unsigned int u32;
typedef __attribute__((ext_vector_type(4))) unsigned u32x4;
typedef __attribute__((ext_vector_type(2))) unsigned u32x2;
typedef __attribute__((ext_vector_type(8))) short bf16x8;
typedef __attribute__((ext_vector_type(4))) short s16x4;
typedef __attribute__((ext_vector_type(16))) float f32x16;
typedef __attribute__((ext_vector_type(2))) float f32x2;
typedef __attribute__((ext_vector_type(4))) float f32x4;
typedef __attribute__((ext_vector_type(2))) __bf16 bf16x2;
typedef const float __attribute__((address_space(4)))* cfptr;

constexpr int T_ = 32768, S_ = 8192, TH_ = 16384;
constexpr int CH_L = 128;
constexpr int CH_C = S_ / CH_L;
constexpr int NPHASE = 17;

constexpr size_t MiB = 1u << 20;
constexpr size_t OFF_WINT = 0;
constexpr size_t OFF_WOUTT = 7 * MiB;
constexpr size_t OFF_WQT = 9 * MiB;
constexpr size_t OFF_WGT = 13 * MiB;
constexpr size_t OFF_WPT = 15 * MiB;
constexpr size_t OFF_WLT = 15 * MiB + 512 * 1024;
constexpr size_t OFF_SUBK = 16 * MiB + 512 * 1024;
constexpr size_t OFF_ROPE = 17 * MiB;
constexpr size_t OFF_CTR = 19 * MiB;
constexpr size_t OFF_ACT = 20 * MiB;
constexpr size_t OFF_QK = 84 * MiB;
constexpr size_t OFF_VT = 148 * MiB;
constexpr size_t OFF_ZRW = 180 * MiB;
constexpr size_t OFF_V = 292 * MiB;
constexpr size_t OFF_AL = 356 * MiB;
constexpr size_t OFF_DD = 420 * MiB;
constexpr size_t OFF_L16 = 388 * MiB;
constexpr size_t OFF_PM = 100 * MiB;
constexpr size_t OFF_HM = 132 * MiB;
constexpr size_t OFF_BE = 180 * MiB;
constexpr size_t OFF_G16 = 244 * MiB;
constexpr size_t OFF_Q16 = 84 * MiB;
constexpr size_t OFF_ST = 148 * MiB;
constexpr size_t OFF_IDX = 276 * MiB;
constexpr size_t OFF_GATE = 292 * MiB;
constexpr size_t OFF_PU16 = 308 * MiB;
constexpr size_t OFF_PV16 = 340 * MiB;
constexpr size_t OFF_P16 = 468 * MiB;

struct Params {
  const float *x, *p; const int* pos;
  const float *norm_mix_g, *w_in, *lam_q1, *lam_k1, *lam_q2, *lam_k2, *subln_g;
  const float *rw_mu, *rw_w0, *rw_w_up, *rw_a0, *rw_a_up, *rw_g_up, *rw_k_k, *rw_k_a, *rw_r_k, *rw_ln_g, *rw_ln_b;
  const float *w_out, *norm_ffn_g, *peer_w_q, *peer_sub_keys, *peer_u, *peer_v, *norm_ple_g, *ple_gate_w, *ple_proj_w, *norm_final_g;
  float* out; char* ws;
  float inv_freq[8];
  int ph_lo, ph_hi;
};

DI u32 pack2(float a, float b) { f32x2 v = {a, b}; bf16x2 r = __builtin_convertvector(v, bf16x2); return __builtin_bit_cast(u32, r); }
DI u16 f2bf(float a) { return (u16)(pack2(a, 0.f) & 0xffffu); }
DI float bflo(u32 v) { return __uint_as_float(v << 16); }
DI float bfhi(u32 v) { return __uint_as_float(v & 0xffff0000u); }
DI f32x16 mfma32(bf16x8 a, bf16x8 b, f32x16 c) { return __builtin_amdgcn_mfma_f32_32x32x16_bf16(a, b, c, 0, 0, 0); }
DI int crow(int i, int h) { return (i & 3) + 8 * (i >> 2) + 4 * h; }
template <int CTRL> DI float dppf(float x) { return __int_as_float(__builtin_amdgcn_update_dpp(0, __float_as_int(x), CTRL, 0xf, 0xf, false)); }
DI float sum8(float x) { x += dppf<0xB1>(x); x += dppf<0x4E>(x); x += dppf<0x141>(x); return x; }
DI float rlf(float x, int l) { return __int_as_float(__builtin_amdgcn_readlane(__float_as_int(x), l)); }
DI float wave_sum(float x) {
  x = sum8(x); x += dppf<0x140>(x);
  return (rlf(x, 0) + rlf(x, 16)) + (rlf(x, 32) + rlf(x, 48));
}
DI float xor32(float x) { return __shfl_xor(x, 32); }
DI cfptr to_const(const float* p) { return (cfptr)(uintptr_t)p; }
DI float sigmoidf_(float x) { return 1.f / (1.f + __expf(-x)); }
DI float dot8(u32x4 a, u32x4 b, float acc) {
  acc = fmaf(bflo(a.x), bflo(b.x), acc); acc = fmaf(bfhi(a.x), bfhi(b.x), acc);
  acc = fmaf(bflo(a.y), bflo(b.y), acc); acc = fmaf(bfhi(a.y), bfhi(b.y), acc);
  acc = fmaf(bflo(a.z), bflo(b.z), acc); acc = fmaf(bfhi(a.z), bfhi(b.z), acc);
  acc = fmaf(bflo(a.w), bflo(b.w), acc); acc = fmaf(bfhi(a.w), bfhi(b.w), acc);
  return acc;
}

constexpr int LDS_LD = 72;
constexpr int G_BUF = 2 * 128 * LDS_LD;
DI void gemm_tile(f32x16 (&acc)[2][2], const u16* Wt, int ldw, const u16* X, int ldx, int K, u16* sW, u16* sX) {
  const int tid = threadIdx.x, lane = tid & 63, wave = tid >> 6;
  const int wn = wave >> 1, wm = wave & 1, r = lane & 31, h = lane >> 5;
  const u16* gw = Wt + (size_t)(tid >> 3) * ldw + (tid & 7) * 8;
  const u16* gx = X + (size_t)(tid >> 3) * ldx + (tid & 7) * 8;
  u16* lw = sW + (tid >> 3) * LDS_LD + (tid & 7) * 8;
  u16* lx = sX + (tid >> 3) * LDS_LD + (tid & 7) * 8;
  const size_t sw32 = (size_t)32 * ldw, sx32 = (size_t)32 * ldx;
  const u16* pa = sW + (wn * 64 + r) * LDS_LD + h * 8;
  const u16* pb = sX + (wm * 64 + r) * LDS_LD + h * 8;
  const int nk = K >> 6;
  u32x4 r0w[4], r0x[4], r1w[4], r1x[4];
#define G_LOAD(RW, RX, kt) { _Pragma("unroll") for (int i = 0; i < 4; ++i) { RW[i] = *(const u32x4*)(gw + i * sw32 + (kt) * 64); RX[i] = *(const u32x4*)(gx + i * sx32 + (kt) * 64); } }
#define G_STORE(RW, RX, st) { _Pragma("unroll") for (int i = 0; i < 4; ++i) { *(u32x4*)(lw + (st) * G_BUF + i * 32 * LDS_LD) = RW[i]; *(u32x4*)(lx + (st) * G_BUF + i * 32 * LDS_LD) = RX[i]; } }
#define G_COMPUTE(st) { _Pragma("unroll") for (int ks = 0; ks < 4; ++ks) { bf16x8 a[2], b[2]; \
    _Pragma("unroll") for (int i = 0; i < 2; ++i) { a[i] = *(const bf16x8*)(pa + (st) * G_BUF + i * 32 * LDS_LD + ks * 16); b[i] = *(const bf16x8*)(pb + (st) * G_BUF + i * 32 * LDS_LD + ks * 16); } \
    _Pragma("unroll") for (int i = 0; i < 2; ++i) _Pragma("unroll") for (int jj = 0; jj < 2; ++jj) acc[i][jj] = mfma32(a[i], b[jj], acc[i][jj]); } }
  G_LOAD(r0w, r0x, 0)
  __syncthreads();
  G_STORE(r0w, r0x, 0)
  G_LOAD(r0w, r0x, 1)
  if (nk > 2) G_LOAD(r1w, r1x, 2)
  __syncthreads();
  for (int k = 0; k < nk; k += 2) {
    G_COMPUTE(0)
    G_STORE(r0w, r0x, 1)
    if (k + 3 < nk) G_LOAD(r0w, r0x, k + 3)
    __syncthreads();
    G_COMPUTE(1)
    if (k + 2 < nk) {
      G_STORE(r1w, r1x, 0)
      if (k + 4 < nk) G_LOAD(r1w, r1x, k + 4)
      __syncthreads();
    }
  }
#undef G_LOAD
#undef G_STORE
#undef G_COMPUTE
}
DI void zero_acc(f32x16 (&acc)[2][2]) {
#pragma unroll
  for (int i = 0; i < 2; ++i)
#pragma unroll
    for (int j = 0; j < 2; ++j)
#pragma unroll
      for (int k = 0; k < 16; ++k) acc[i][j][k] = 0.f;
}

DI void transpose_tile(const float* src, int N, int kt, int nt, u16* dst, int ldd, int kofs, bool valid, float* tile) {
  const int tid = threadIdx.x;
  if (valid) {
#pragma unroll 4
    for (int i = 0; i < 16; ++i) {
      int idx = tid + 256 * i, kk = idx >> 6, nn = idx & 63;
      tile[kk * 65 + nn] = src[(size_t)(kt * 64 + kk) * N + nt * 64 + nn];
    }
  }
  __syncthreads();
#pragma unroll 4
  for (int i = 0; i < 16; ++i) {
    int idx = tid + 256 * i, nn = idx >> 6, kk = idx & 63;
    float v = valid ? tile[kk * 65 + nn] : 0.f;
    dst[(size_t)(nt * 64 + nn) * ldd + kofs + kt * 64 + kk] = f2bf(v);
  }
  __syncthreads();
}
DI void transpose_all(const float* src, int K, int N, u16* dst, float* tile) {
  int KT = K / 64, NTt = N / 64;
  for (int t = blockIdx.x; t < KT * NTt; t += gridDim.x) transpose_tile(src, N, t % KT, t / KT, dst, K, 0, true, tile);
}
DI void convert_flat(const float* src, u16* dst, size_t n) {
  size_t n4 = n / 4;
  for (size_t i = (size_t)blockIdx.x * 256 + threadIdx.x; i < n4; i += (size_t)gridDim.x * 256) {
    float4 v = ((const float4*)src)[i];
    u32x2 o = {pack2(v.x, v.y), pack2(v.z, v.w)};
    ((u32x2*)dst)[i] = o;
  }
}
DI void convert_fp8(const float* src, unsigned char* dst, size_t n, float scale) {
  size_t n8 = n / 8;
  for (size_t i = (size_t)blockIdx.x * 256 + threadIdx.x; i < n8; i += (size_t)gridDim.x * 256) {
    float4 a = ((const float4*)src)[2 * i], b = ((const float4*)src)[2 * i + 1];
    int r0 = __builtin_amdgcn_cvt_pk_fp8_f32(a.x * scale, a.y * scale, 0, false);
    r0 = __builtin_amdgcn_cvt_pk_fp8_f32(a.z * scale, a.w * scale, r0, true);
    int r1 = __builtin_amdgcn_cvt_pk_fp8_f32(b.x * scale, b.y * scale, 0, false);
    r1 = __builtin_amdgcn_cvt_pk_fp8_f32(b.z * scale, b.w * scale, r1, true);
    u32x2 o = {(u32)r0, (u32)r1};
    ((u32x2*)dst)[i] = o;
  }
}
DI void convert_fp4(const float* src, unsigned char* dst, size_t n, float scale) {
  size_t n8 = n / 8;
  for (size_t i = (size_t)blockIdx.x * 256 + threadIdx.x; i < n8; i += (size_t)gridDim.x * 256) {
    float4 a = ((const float4*)src)[2 * i], b = ((const float4*)src)[2 * i + 1];
    u32 r = 0u;
    r = __builtin_amdgcn_cvt_scalef32_pk_fp4_f32(r, a.x * scale, a.y * scale, 1.0f, 0);
    r = __builtin_amdgcn_cvt_scalef32_pk_fp4_f32(r, a.z * scale, a.w * scale, 1.0f, 1);
    r = __builtin_amdgcn_cvt_scalef32_pk_fp4_f32(r, b.x * scale, b.y * scale, 1.0f, 2);
    r = __builtin_amdgcn_cvt_scalef32_pk_fp4_f32(r, b.z * scale, b.w * scale, 1.0f, 3);
    ((u32*)dst)[i] = r;
  }
}
DI void fp4x8_to_f32(u32 w, float* f) {
  f32x2 p0 = __builtin_amdgcn_cvt_scalef32_pk_f32_fp4(w, 1.0f, 0), p1 = __builtin_amdgcn_cvt_scalef32_pk_f32_fp4(w, 1.0f, 1);
  f32x2 p2 = __builtin_amdgcn_cvt_scalef32_pk_f32_fp4(w, 1.0f, 2), p3 = __builtin_amdgcn_cvt_scalef32_pk_f32_fp4(w, 1.0f, 3);
  f[0] = p0.x; f[1] = p0.y; f[2] = p1.x; f[3] = p1.y; f[4] = p2.x; f[5] = p2.y; f[6] = p3.x; f[7] = p3.y;
}
DI u32 pack_fp4x8(const float4 a, const float4 b, float scale) {
  u32 r = 0u;
  r = __builtin_amdgcn_cvt_scalef32_pk_fp4_f32(r, a.x * scale, a.y * scale, 1.0f, 0);
  r = __builtin_amdgcn_cvt_scalef32_pk_fp4_f32(r, a.z * scale, a.w * scale, 1.0f, 1);
  r = __builtin_amdgcn_cvt_scalef32_pk_fp4_f32(r, b.x * scale, b.y * scale, 1.0f, 2);
  r = __builtin_amdgcn_cvt_scalef32_pk_fp4_f32(r, b.z * scale, b.w * scale, 1.0f, 3);
  return r;
}
DI void convert_uv_fp4(const float* u, const float* v, unsigned char* dst, float su, float sv) {
  const size_t n = (size_t)16384 * 64;
  for (size_t i = (size_t)blockIdx.x * 256 + threadIdx.x; i < n; i += (size_t)gridDim.x * 256) {
    const float4* pu = (const float4*)(u + i * 16); const float4* pv = (const float4*)(v + i * 16);
    u32x4 o = {pack_fp4x8(pu[0], pu[1], su), pack_fp4x8(pu[2], pu[3], su), pack_fp4x8(pv[0], pv[1], sv), pack_fp4x8(pv[2], pv[3], sv)};
    ((u32x4*)dst)[i] = o;
  }
}
DI void rmsnorm_rows(const float* src, const float* g, u16* dst) {
  const int lane = threadIdx.x & 63, wave = threadIdx.x >> 6;
  for (int t = blockIdx.x * 4 + wave; t < T_; t += gridDim.x * 4) {
    const float4* row = (const float4*)(src + (size_t)t * 1024);
    float4 v[4]; float ss = 0.f;
#pragma unroll
    for (int i = 0; i < 4; ++i) { v[i] = row[lane + 64 * i]; ss += v[i].x * v[i].x + v[i].y * v[i].y + v[i].z * v[i].z + v[i].w * v[i].w; }
    ss = wave_sum(ss);
    float rs = rsqrtf(ss * (1.f / 1024.f) + 1e-6f);
#pragma unroll
    for (int i = 0; i < 4; ++i) {
      float4 gg = ((const float4*)g)[lane + 64 * i];
      u32x2 o = {pack2(v[i].x * rs * gg.x, v[i].y * rs * gg.y), pack2(v[i].z * rs * gg.z, v[i].w * rs * gg.w)};
      ((u32x2*)(dst + (size_t)t * 1024))[lane + 64 * i] = o;
    }
  }
}
DI void phase_prep(const Params& P, char* smem) {
  float* tile = (float*)smem;
  char* ws = P.ws;
  transpose_all(P.w_in, 1024, 3328, (u16*)(ws + OFF_WINT), tile);
  transpose_all(P.w_out, 1024, 1024, (u16*)(ws + OFF_WOUTT), tile);
  transpose_all(P.peer_w_q, 1024, 2048, (u16*)(ws + OFF_WQT), tile);
  transpose_all(P.ple_gate_w, 1024, 1024, (u16*)(ws + OFF_WGT), tile);
  transpose_all(P.ple_proj_w, 256, 1024, (u16*)(ws + OFF_WPT), tile);
  for (int t = blockIdx.x; t < 24 * 4; t += gridDim.x) {
    int nt = t >> 2, kt = t & 3, sec = nt >> 3, ntl = nt & 7;
    const float* src; int kts; bool valid;
    if (sec == 0) { src = P.rw_w_up; valid = (kt == 0); kts = 0; }
    else if (sec == 1) { src = P.rw_a_up; valid = (kt == 1); kts = 0; }
    else { src = P.rw_g_up; valid = (kt >= 2); kts = kt - 2; }
    transpose_tile(src, 512, kts, ntl, (u16*)(ws + OFF_WLT) + (size_t)sec * 512 * 256, 256, (kt - kts) * 64, valid, tile);
  }
  convert_flat(P.peer_sub_keys, (u16*)(ws + OFF_SUBK), (size_t)16 * 128 * 128);
  float2* rope = (float2*)(ws + OFF_ROPE);
  for (int i = blockIdx.x * 256 + threadIdx.x; i < T_ * 8; i += gridDim.x * 256) {
    int m = i >> 3, f = i & 7;
    float ang = (float)P.pos[m] * P.inv_freq[f];
    double a = (double)ang;
    double k = rint(a * 0.15915494309189535);
    float rr = (float)(a - k * 6.283185307179586);
    rope[i] = make_float2(__cosf(rr), __sinf(rr));
  }
  rmsnorm_rows(P.x, P.norm_mix_g, (u16*)(ws + OFF_ACT));
}

DI void phase_gemm1(const Params& P, char* smem) {
  u16* sW = (u16*)smem; u16* sX = sW + 128 * LDS_LD;
  char* ws = P.ws;
  const u16* WinT = (const u16*)(ws + OFF_WINT); const u16* ACT = (const u16*)(ws + OFF_ACT);
  const float2* rope = (const float2*)(ws + OFF_ROPE);
  u16* QK = (u16*)(ws + OFF_QK); u16* VT = (u16*)(ws + OFF_VT); u16* ZRW = (u16*)(ws + OFF_ZRW);
  const int lane = threadIdx.x & 63, wave = threadIdx.x >> 6, wn = wave >> 1, wm = wave & 1, r = lane & 31, h = lane >> 5;
  constexpr int NT = 26, MT = 256;
  for (int tile = blockIdx.x; tile < NT * MT; tile += gridDim.x) {
    int mt = tile / NT, nt = tile % NT;
    f32x16 acc[2][2]; zero_acc(acc);
    gemm_tile(acc, WinT + (size_t)nt * 128 * 1024, 1024, ACT + (size_t)mt * 128 * 1024, 1024, 1024, sW, sX);
#pragma unroll
    for (int ai = 0; ai < 2; ++ai)
#pragma unroll
      for (int bi = 0; bi < 2; ++bi) {
        const int nb = nt * 128 + wn * 64 + ai * 32;
        const int m = mt * 128 + wm * 64 + bi * 32 + r;
        f32x16 v = acc[ai][bi];
        if (nb < 1024) {
          if ((nb & 63) == 0) {
#pragma unroll
            for (int i = 0; i < 4; ++i) {
              float2 cs = rope[m * 8 + 4 * h + i];
              float t1 = v[i], t2 = v[i + 4];
              v[i] = t1 * cs.x - t2 * cs.y; v[i + 4] = t2 * cs.x + t1 * cs.y;
            }
          }
          if (nb < 512) {
#pragma unroll
            for (int i = 0; i < 16; ++i) v[i] *= 0.125f;
          }
#pragma unroll
          for (int q = 0; q < 4; ++q) {
            u32x2 pk = {pack2(v[4 * q], v[4 * q + 1]), pack2(v[4 * q + 2], v[4 * q + 3])};
            *(u32x2*)(QK + (size_t)m * 1024 + nb + 8 * q + 4 * h) = pk;
          }
        } else if (nb < 1536) {
          const int hh = (nb - 1024) >> 7, dv0 = (nb - 1024) & 127, b = m >> 13, s = m & 8191;
#pragma unroll
          for (int i = 0; i < 16; ++i) VT[((size_t)((b * 4 + hh) * 128 + dv0 + crow(i, h))) * S_ + s] = f2bf(v[i]);
        } else {
#pragma unroll
          for (int q = 0; q < 4; ++q) {
            u32x2 pk = {pack2(v[4 * q], v[4 * q + 1]), pack2(v[4 * q + 2], v[4 * q + 3])};
            *(u32x2*)(ZRW + (size_t)m * 1792 + (nb - 1536) + 8 * q + 4 * h) = pk;
          }
        }
      }
  }
}

DI void phase_attn(const Params& P, char* smem) {
  constexpr int ATT_BUF = (64 + 128) * LDS_LD;
  u16* sK = (u16*)smem;
  u16* sV = sK + 64 * LDS_LD;
  int* sItem = (int*)(sK + 2 * ATT_BUF);
  char* ws = P.ws;
  const u16* QK = (const u16*)(ws + OFF_QK); const u16* VT = (const u16*)(ws + OFF_VT);
  u16* CAT = (u16*)(ws + OFF_ACT);
  unsigned* ctr = (unsigned*)(ws + OFF_CTR);
  const int tid = threadIdx.x, lane = tid & 63, wave = tid >> 6, r = lane & 31, h = lane >> 5;
  float d1 = 0.f, d2 = 0.f;
  for (int i = 0; i < 64; ++i) { d1 += P.lam_q1[i] * P.lam_k1[i]; d2 += P.lam_q2[i] * P.lam_k2[i]; }
  const float lam = expf(d1) - expf(d2) + 0.2f;
  const float LOG2E = 1.4426950408889634f;
  for (;;) {
    __syncthreads();
    if (tid == 0) *sItem = (int)atomicAdd(ctr, 1u);
    __syncthreads();
    const int item = *sItem;
    if (item >= 1024) break;
    const int qt = 63 - (item >> 4), bh = item & 15, b = bh >> 2, hh = bh & 3;
    const int qlo = qt * 128 + wave * 32;
    const size_t mq = (size_t)b * S_ + qlo + r;
    const int ntiles = 2 * qt + 2;
    float4* scr = (float4*)(ws + 324 * MiB) + (size_t)blockIdx.x * 16 * 256 + tid;
#pragma unroll
    for (int c = 0; c < 2; ++c) {
      bf16x8 qf[4];
#pragma unroll
      for (int ks = 0; ks < 4; ++ks) qf[ks] = *(const bf16x8*)(QK + mq * 1024 + hh * 128 + c * 64 + ks * 16 + h * 8);
      f32x16 o[4];
#pragma unroll
      for (int d = 0; d < 4; ++d)
#pragma unroll
        for (int i = 0; i < 16; ++i) o[d][i] = 0.f;
      float mrow = -1e30f, lsum = 0.f;
      const u16* kbase = QK + ((size_t)b * S_) * 1024 + 512 + hh * 128 + c * 64;
      const u16* vbase = VT + ((size_t)(b * 4 + hh) * 128) * S_;
      u32x4 rk[2], rv[4];
#pragma unroll
      for (int i = 0; i < 2; ++i) { int cc = tid + 256 * i, row = cc >> 3, kc = cc & 7; rk[i] = *(const u32x4*)(kbase + (size_t)row * 1024 + kc * 8); }
#pragma unroll
      for (int i = 0; i < 4; ++i) { int cc = tid + 256 * i, row = cc >> 3, kc = cc & 7; rv[i] = *(const u32x4*)(vbase + (size_t)row * S_ + kc * 8); }
      __syncthreads();
#pragma unroll
      for (int i = 0; i < 2; ++i) { int cc = tid + 256 * i, row = cc >> 3, kc = cc & 7; *(u32x4*)(sK + row * LDS_LD + kc * 8) = rk[i]; }
#pragma unroll
      for (int i = 0; i < 4; ++i) { int cc = tid + 256 * i, row = cc >> 3, kc = cc & 7; *(u32x4*)(sV + row * LDS_LD + kc * 8) = rv[i]; }
      __syncthreads();
      for (int j = 0; j < ntiles; ++j) {
        const int cur = j & 1;
        const u16* sKc = sK + cur * ATT_BUF; const u16* sVc = sV + cur * ATT_BUF;
        u16* sKn = sK + (cur ^ 1) * ATT_BUF; u16* sVn = sV + (cur ^ 1) * ATT_BUF;
        const bool more = (j + 1 < ntiles);
        if (more) {
          const int k0 = (j + 1) * 64;
#pragma unroll
          for (int i = 0; i < 2; ++i) { int cc = tid + 256 * i, row = cc >> 3, kc = cc & 7; rk[i] = *(const u32x4*)(kbase + (size_t)(k0 + row) * 1024 + kc * 8); }
#pragma unroll
          for (int i = 0; i < 4; ++i) { int cc = tid + 256 * i, row = cc >> 3, kc = cc & 7; rv[i] = *(const u32x4*)(vbase + (size_t)row * S_ + k0 + kc * 8); }
        }
        f32x16 st[2];
        float mnew = 0.f;
        const int key0 = j * 64;
        if (key0 <= qlo + 31) {
#pragma unroll
          for (int kb = 0; kb < 2; ++kb) {
#pragma unroll
            for (int i = 0; i < 16; ++i) st[kb][i] = 0.f;
#pragma unroll
            for (int ks = 0; ks < 4; ++ks) {
              bf16x8 kf = *(const bf16x8*)(sKc + (kb * 32 + r) * LDS_LD + ks * 16 + h * 8);
              st[kb] = mfma32(kf, qf[ks], st[kb]);
            }
          }
          const bool need_mask = (key0 + 63 > qlo);
          float mx = -1e30f;
#pragma unroll
          for (int kb = 0; kb < 2; ++kb)
#pragma unroll
            for (int i = 0; i < 16; ++i) {
              float s = st[kb][i] * LOG2E;
              if (need_mask) { int key = key0 + kb * 32 + crow(i, h); if (key > qlo + r) s = -1e30f; }
              st[kb][i] = s; mx = fmaxf(mx, s);
            }
          mx = fmaxf(mx, xor32(mx));
          mnew = fmaxf(mrow, mx);
          const float alpha = __builtin_amdgcn_exp2f(mrow - mnew);
          mrow = mnew;
          float ps = 0.f;
#pragma unroll
          for (int kb = 0; kb < 2; ++kb)
#pragma unroll
            for (int i = 0; i < 16; ++i) { float p = __builtin_amdgcn_exp2f(st[kb][i] - mnew); st[kb][i] = p; ps += p; }
          lsum = lsum * alpha + ps;
#pragma unroll
          for (int d = 0; d < 4; ++d)
#pragma unroll
            for (int i = 0; i < 16; ++i) o[d][i] *= alpha;
        }
        if (more) {
#pragma unroll
          for (int i = 0; i < 2; ++i) { int cc = tid + 256 * i, row = cc >> 3, kc = cc & 7; *(u32x4*)(sKn + row * LDS_LD + kc * 8) = rk[i]; }
#pragma unroll
          for (int i = 0; i < 4; ++i) { int cc = tid + 256 * i, row = cc >> 3, kc = cc & 7; *(u32x4*)(sVn + row * LDS_LD + kc * 8) = rv[i]; }
        }
        if (key0 <= qlo + 31) {
#pragma unroll
          for (int kb = 0; kb < 2; ++kb)
#pragma unroll
            for (int s = 0; s < 2; ++s) {
              u32x4 pp = {pack2(st[kb][8 * s], st[kb][8 * s + 1]), pack2(st[kb][8 * s + 2], st[kb][8 * s + 3]),
                          pack2(st[kb][8 * s + 4], st[kb][8 * s + 5]), pack2(st[kb][8 * s + 6], st[kb][8 * s + 7])};
              bf16x8 pf = __builtin_bit_cast(bf16x8, pp);
#pragma unroll
              for (int d = 0; d < 4; ++d) {
                const u16* vp = sVc + (d * 32 + r) * LDS_LD + kb * 32 + 16 * s + 4 * h;
                s16x4 lo = *(const s16x4*)vp, hi = *(const s16x4*)(vp + 8);
                bf16x8 vf = __builtin_shufflevector(lo, hi, 0, 1, 2, 3, 4, 5, 6, 7);
                o[d] = mfma32(vf, pf, o[d]);
              }
            }
        }
        __syncthreads();
      }
      const float ltot = lsum + xor32(lsum);
      const float inv = 1.f / ltot;
      if (c == 0) {
#pragma unroll
        for (int d = 0; d < 4; ++d)
#pragma unroll
          for (int q = 0; q < 4; ++q) scr[(d * 4 + q) * 256] = make_float4(o[d][4 * q] * inv, o[d][4 * q + 1] * inv, o[d][4 * q + 2] * inv, o[d][4 * q + 3] * inv);
      } else {
        float ss = 0.f;
        const float li = lam * inv;
#pragma unroll
        for (int d = 0; d < 4; ++d)
#pragma unroll
          for (int q = 0; q < 4; ++q) {
            float4 p0 = scr[(d * 4 + q) * 256];
            float v0 = p0.x - li * o[d][4 * q], v1 = p0.y - li * o[d][4 * q + 1], v2 = p0.z - li * o[d][4 * q + 2], v3 = p0.w - li * o[d][4 * q + 3];
            o[d][4 * q] = v0; o[d][4 * q + 1] = v1; o[d][4 * q + 2] = v2; o[d][4 * q + 3] = v3;
            ss += v0 * v0 + v1 * v1 + v2 * v2 + v3 * v3;
          }
        ss += xor32(ss);
        const float rs = rsqrtf(ss * (1.f / 128.f) + 1e-6f) * 0.8f;
#pragma unroll
        for (int d = 0; d < 4; ++d)
#pragma unroll
          for (int q = 0; q < 4; ++q) {
            const int dv = d * 32 + 8 * q + 4 * h;
            float4 g = *(const float4*)(P.subln_g + dv);
            u32x2 pk = {pack2(o[d][4 * q] * rs * g.x, o[d][4 * q + 1] * rs * g.y), pack2(o[d][4 * q + 2] * rs * g.z, o[d][4 * q + 3] * rs * g.w)};
            *(u32x2*)(CAT + mq * 1024 + hh * 128 + dv) = pk;
          }
      }
    }
  }
}

DI void load8(const u16* p, float (&f)[8]) {
  u32x4 v = *(const u32x4*)p;
  f[0] = bflo(v.x); f[1] = bfhi(v.x); f[2] = bflo(v.y); f[3] = bfhi(v.y); f[4] = bflo(v.z); f[5] = bfhi(v.z); f[6] = bflo(v.w); f[7] = bfhi(v.w);
}
DI void shift8(const u16* zc, bool first, const float* mu, float (&z)[8]) {
  float c[8], p[8];
  load8(zc, c);
  if (first) { for (int e = 0; e < 8; ++e) p[e] = 0.f; } else load8(zc - 1792, p);
  float4 m0 = *(const float4*)mu, m1 = *(const float4*)(mu + 4);
  float mm[8] = {m0.x, m0.y, m0.z, m0.w, m1.x, m1.y, m1.z, m1.w};
#pragma unroll
  for (int e = 0; e < 8; ++e) z[e] = c[e] + (p[e] - c[e]) * mm[e];
}
DI void store8h(u16* dst, const float (&z)[8]) {
  u32x4 o = {pack2(z[0], z[1]), pack2(z[2], z[3]), pack2(z[4], z[5]), pack2(z[6], z[7])};
  *(u32x4*)dst = o;
}
DI void store8f(float* dst, const float (&z)[8]) {
  *(float4*)dst = make_float4(z[0], z[1], z[2], z[3]); *(float4*)(dst + 4) = make_float4(z[4], z[5], z[6], z[7]);
}
DI void phase_rwprep(const Params& P) {
  char* ws = P.ws;
  const u16* ZRW = (const u16*)(ws + OFF_ZRW);
  u16* Rb = (u16*)P.out; u16* Kb = (u16*)P.out + (size_t)T_ * 512;
  u16* Vb = (u16*)(ws + OFF_V); u16* ALb = (u16*)(ws + OFF_AL); u16* L16 = (u16*)(ws + OFF_L16);
  const int lane = threadIdx.x & 63, wave = threadIdx.x >> 6;
  for (int t = blockIdx.x * 4 + wave; t < T_; t += gridDim.x * 4) {
    const bool first = (t & (S_ - 1)) == 0;
    const u16* zc = ZRW + (size_t)t * 1792;
    float z[8];
    shift8(zc + lane * 8, first, P.rw_mu + lane * 8, z);
    store8h(Rb + (size_t)t * 512 + lane * 8, z);
    shift8(zc + 512 + lane * 8, first, P.rw_mu + 512 + lane * 8, z);
    store8h(Kb + (size_t)t * 512 + lane * 8, z);
    {
      float4 k0 = *(const float4*)(P.rw_k_k + lane * 8), k1 = *(const float4*)(P.rw_k_k + lane * 8 + 4);
      float kk[8] = {z[0] * k0.x, z[1] * k0.y, z[2] * k0.z, z[3] * k0.w, z[4] * k1.x, z[5] * k1.y, z[6] * k1.z, z[7] * k1.w};
      float ss = 0.f;
#pragma unroll
      for (int e = 0; e < 8; ++e) ss += kk[e] * kk[e];
      ss = sum8(ss);
      float inv = -1.f / fmaxf(sqrtf(ss), 1e-12f);
#pragma unroll
      for (int e = 0; e < 8; ++e) kk[e] *= inv;
      store8h(ALb + (size_t)t * 512 + lane * 8, kk);
    }
    shift8(zc + 1024 + lane * 8, first, P.rw_mu + 1024 + lane * 8, z);
    store8h(Vb + (size_t)t * 512 + lane * 8, z);
    if (lane < 32) {
      shift8(zc + 1536 + lane * 8, first, P.rw_mu + 1536 + lane * 8, z);
      if (lane < 8) { for (int e = 0; e < 8; ++e) z[e] = tanhf(z[e]); }
      else if (lane >= 16) { for (int e = 0; e < 8; ++e) z[e] = sigmoidf_(z[e]); }
      u32x4 o = {pack2(z[0], z[1]), pack2(z[2], z[3]), pack2(z[4], z[5]), pack2(z[6], z[7])};
      *(u32x4*)(L16 + (size_t)t * 256 + lane * 8) = o;
    }
  }
}

DI void phase_lora(const Params& P, char* smem) {
  u16* sW = (u16*)smem; u16* sX = sW + 128 * LDS_LD;
  char* ws = P.ws;
  const u16* WlT = (const u16*)(ws + OFF_WLT); const u16* L16 = (const u16*)(ws + OFF_L16);
  u16* Kb = (u16*)P.out + (size_t)T_ * 512; const u16* ALb = (const u16*)(ws + OFF_AL);
  u16* BEb = (u16*)(ws + OFF_BE); float* DDb = (float*)(ws + OFF_DD); u16* G16 = (u16*)(ws + OFF_G16);
  const int lane = threadIdx.x & 63, wave = threadIdx.x >> 6, wn = wave >> 1, wm = wave & 1, r = lane & 31, h = lane >> 5;
  constexpr int NT = 12, MT = 256;
  for (int tile = blockIdx.x; tile < NT * MT; tile += gridDim.x) {
    int mt = tile / NT, nt = tile % NT;
    f32x16 acc[2][2]; zero_acc(acc);
    gemm_tile(acc, WlT + (size_t)nt * 128 * 256, 256, L16 + (size_t)mt * 128 * 256, 256, 256, sW, sX);
#pragma unroll
    for (int ai = 0; ai < 2; ++ai)
#pragma unroll
      for (int bi = 0; bi < 2; ++bi) {
        const int nb = nt * 128 + wn * 64 + ai * 32;
        const size_t m = mt * 128 + wm * 64 + bi * 32 + r;
        const f32x16 v = acc[ai][bi];
#pragma unroll
        for (int q = 0; q < 4; ++q) {
          const int ch = (nb & 511) + 8 * q + 4 * h;
          float a4[4] = {v[4 * q], v[4 * q + 1], v[4 * q + 2], v[4 * q + 3]};
          if (nb < 512) {
            float4 w0 = *(const float4*)(P.rw_w0 + ch);
            float ww[4] = {w0.x, w0.y, w0.z, w0.w}, dd[4];
#pragma unroll
            for (int e = 0; e < 4; ++e) {
              float xx = -(ww[e] + a4[e]);
              float sp = fmaxf(xx, 0.f) + log1pf(__expf(-fabsf(xx)));
              float w = -sp - 0.5f;
              dd[e] = __expf(-__expf(w));
            }
            *(float4*)(DDb + m * 512 + ch) = make_float4(dd[0], dd[1], dd[2], dd[3]);
          } else if (nb < 1024) {
            float4 a0 = *(const float4*)(P.rw_a0 + ch), ka = *(const float4*)(P.rw_k_a + ch);
            const u32x2 kvp = *(const u32x2*)(Kb + m * 512 + ch), alp = *(const u32x2*)(ALb + m * 512 + ch);
            const float kv[4] = {bflo(kvp.x), bfhi(kvp.x), bflo(kvp.y), bfhi(kvp.y)}, al[4] = {bflo(alp.x), bfhi(alp.x), bflo(alp.y), bfhi(alp.y)};
            float aa[4] = {sigmoidf_(a0.x + a4[0]), sigmoidf_(a0.y + a4[1]), sigmoidf_(a0.z + a4[2]), sigmoidf_(a0.w + a4[3])};
            u32x2 bo = {pack2(-al[0] * aa[0], -al[1] * aa[1]), pack2(-al[2] * aa[2], -al[3] * aa[3])};
            *(u32x2*)(BEb + m * 512 + ch) = bo;
            u32x2 ko = {pack2(kv[0] * (1.f + (aa[0] - 1.f) * ka.x), kv[1] * (1.f + (aa[1] - 1.f) * ka.y)),
                        pack2(kv[2] * (1.f + (aa[2] - 1.f) * ka.z), kv[3] * (1.f + (aa[3] - 1.f) * ka.w))};
            *(u32x2*)(Kb + m * 512 + ch) = ko;
          } else {
            u32x2 pk = {pack2(a4[0], a4[1]), pack2(a4[2], a4[3])};
            *(u32x2*)(G16 + m * 512 + ch) = pk;
          }
        }
      }
  }
}

constexpr int SC_TB = 8;
constexpr int SC_WLDS = 6 * SC_TB * 64;
template <int MODE>
DI void scan_chunk(const Params& P, int bh, int c, int lane, float* lds) {
  char* ws = P.ws;
  const int b = bh >> 3, h = bh & 7;
  const size_t tok0 = (size_t)b * S_ + (size_t)c * CH_L;
  const size_t base = tok0 * 512 + h * 64;
  const u16* arh[6] = {(const u16*)(ws + OFF_AL) + base, (const u16*)(ws + OFF_BE) + base, nullptr,
                       (const u16*)P.out + (size_t)T_ * 512 + base, (const u16*)P.out + base, (const u16*)(ws + OFF_V) + base};
  const float* ard = (const float*)(ws + OFF_DD) + base;
  float* PM = (float*)(ws + OFF_PM); float* HM = (float*)(ws + OFF_HM);
  f32x2 SA[32], SB[32];
  if (MODE == 0) {
#pragma unroll
    for (int p = 0; p < 32; ++p) { SA[p].x = (2 * p == lane) ? 1.f : 0.f; SA[p].y = (2 * p + 1 == lane) ? 1.f : 0.f; SB[p].x = 0.f; SB[p].y = 0.f; }
  } else if (c == 0) {
#pragma unroll
    for (int p = 0; p < 32; ++p) { SA[p].x = 0.f; SA[p].y = 0.f; }
  } else {
    const float4* src = (const float4*)(HM + ((size_t)(bh * CH_C + c - 1) * 64 + lane) * 64);
#pragma unroll
    for (int q = 0; q < 16; ++q) { float4 v = src[q]; SA[2 * q].x = v.x; SA[2 * q].y = v.y; SA[2 * q + 1].x = v.z; SA[2 * q + 1].y = v.w; }
  }
  float lng = 0.f, lnb = 0.f, rk = 0.f;
  const u16* G16 = (const u16*)(ws + OFF_G16) + base;
  u16* CAT = (u16*)(ws + OFF_ACT) + tok0 * 1024 + 512 + h * 64;
  if (MODE == 2) { lng = P.rw_ln_g[h * 64 + lane]; lnb = P.rw_ln_b[h * 64 + lane]; rk = P.rw_r_k[h * 64 + lane]; }
  const int st_t = lane >> 4, st_q = (lane & 15) * 4;
#pragma unroll 1
  for (int tb = 0; tb < CH_L / SC_TB; ++tb) {
    {
      u32x4 ph[6]; f32x4 pd[2];
#pragma unroll
      for (int a = 0; a < 6; ++a) {
        if (a == 2 || (MODE == 0 && a == 4)) continue;
        ph[a] = *(const u32x4*)(arh[a] + (size_t)(tb * SC_TB + (lane >> 3)) * 512 + (lane & 7) * 8);
      }
#pragma unroll
      for (int f = 0; f < 2; ++f) pd[f] = *(const f32x4*)(ard + (size_t)(tb * SC_TB + f * 4 + st_t) * 512 + st_q);
#pragma unroll
      for (int a = 0; a < 6; ++a) {
        if (a == 2 || (MODE == 0 && a == 4)) continue;
        float* dst = lds + (a * SC_TB + (lane >> 3)) * 64 + (lane & 7) * 8;
        f32x4 lo = {bflo(ph[a].x), bfhi(ph[a].x), bflo(ph[a].y), bfhi(ph[a].y)}, hi = {bflo(ph[a].z), bfhi(ph[a].z), bflo(ph[a].w), bfhi(ph[a].w)};
        *(f32x4*)dst = lo; *(f32x4*)(dst + 4) = hi;
      }
#pragma unroll
      for (int f = 0; f < 2; ++f) *(f32x4*)(lds + ((4 + f) * 64 + lane) * 4) = pd[f];
    }
#pragma unroll 1
    for (int t = 0; t < SC_TB; ++t) {
      const float* la = lds + t * 64;
      const float vi = la[5 * SC_TB * 64 + lane];
      float gbits = 0.f;
      if (MODE == 2) gbits = __uint_as_float((u32)G16[(size_t)(tb * SC_TB + t) * 512 + lane] << 16);
      f32x2 sa2 = {0.f, 0.f}, sb2 = {0.f, 0.f};
#pragma unroll
      for (int q = 0; q < 16; ++q) {
        if ((q & 3) == 0) asm volatile("" ::: "memory");
        const f32x4 al = *(const f32x4*)(la + 4 * q);
        const f32x2 al0 = {al.x, al.y}, al1 = {al.z, al.w};
        sa2 = SA[2 * q] * al0 + sa2; sa2 = SA[2 * q + 1] * al1 + sa2;
        if (MODE == 0) { sb2 = SB[2 * q] * al0 + sb2; sb2 = SB[2 * q + 1] * al1 + sb2; }
      }
      const float sa = sa2.x + sa2.y, sb = sb2.x + sb2.y;
      const f32x2 sav = {sa, sa}, sbv = {sb, sb}, viv = {vi, vi};
      f32x2 y2 = {0.f, 0.f};
#pragma unroll
      for (int q = 0; q < 16; ++q) {
        if ((q & 1) == 0) asm volatile("" ::: "memory");
        const f32x4 be = *(const f32x4*)(la + 1 * SC_TB * 64 + 4 * q);
        const f32x4 dd = *(const f32x4*)(la + 2 * SC_TB * 64 + 4 * q);
        const f32x4 kk = *(const f32x4*)(la + 3 * SC_TB * 64 + 4 * q);
        const f32x2 be0 = {be.x, be.y}, be1 = {be.z, be.w}, dd0 = {dd.x, dd.y}, dd1 = {dd.z, dd.w}, kk0 = {kk.x, kk.y}, kk1 = {kk.z, kk.w};
        if (MODE == 0) {
          SA[2 * q] = SA[2 * q] * dd0 + sav * be0; SA[2 * q + 1] = SA[2 * q + 1] * dd1 + sav * be1;
          SB[2 * q] = SB[2 * q] * dd0 + (viv * kk0 + sbv * be0); SB[2 * q + 1] = SB[2 * q + 1] * dd1 + (viv * kk1 + sbv * be1);
        } else {
          const f32x4 rr = *(const f32x4*)(la + 4 * SC_TB * 64 + 4 * q);
          const f32x2 rr0 = {rr.x, rr.y}, rr1 = {rr.z, rr.w};
          SA[2 * q] = SA[2 * q] * dd0 + (viv * kk0 + sav * be0); SA[2 * q + 1] = SA[2 * q + 1] * dd1 + (viv * kk1 + sav * be1);
          y2 = SA[2 * q] * rr0 + y2; y2 = SA[2 * q + 1] * rr1 + y2;
        }
      }
      if (MODE == 2) {
        const float y = y2.x + y2.y;
        const float rj = la[4 * SC_TB * 64 + lane], kj = la[3 * SC_TB * 64 + lane];
        const float s1 = wave_sum(y), s2 = wave_sum(y * y), bonus = wave_sum(rj * kj * rk);
        const float mean = s1 * (1.f / 64.f);
        const float dv = y - mean;
        const float var = fmaxf(s2 * (1.f / 64.f) - mean * mean, 0.f);
        float yn = dv * rsqrtf(var + 64e-5f) * lng + lnb;
        yn += bonus * vi;
        CAT[(size_t)(tb * SC_TB + t) * 1024 + lane] = f2bf(yn * gbits);
      }
    }
  }
  if (MODE == 0) {
    float4* dp = (float4*)(PM + ((size_t)(bh * CH_C + c) * 64 + lane) * 64);
    float4* dh = (float4*)(HM + ((size_t)(bh * CH_C + c) * 64 + lane) * 64);
#pragma unroll
    for (int q = 0; q < 16; ++q) {
      dp[q] = make_float4(SA[2 * q].x, SA[2 * q].y, SA[2 * q + 1].x, SA[2 * q + 1].y);
      dh[q] = make_float4(SB[2 * q].x, SB[2 * q].y, SB[2 * q + 1].x, SB[2 * q + 1].y);
    }
  }
}
DI void phase_scan1(const Params& P, char* smem) {
  const int lane = threadIdx.x & 63;
  const int wave = __builtin_amdgcn_readfirstlane((int)(threadIdx.x >> 6));
  float* lds = (float*)smem + wave * SC_WLDS;
  const int nitems = 32 * (CH_C - 1);
  for (int it = blockIdx.x * 4 + wave; it < nitems; it += gridDim.x * 4) scan_chunk<0>(P, it / (CH_C - 1), it % (CH_C - 1), lane, lds);
}
DI void phase_scan2(const Params& P, char* smem) {
  constexpr int SLD = 68;
  float* sA = (float*)smem;
  char* ws = P.ws;
  float* HM = (float*)(ws + OFF_HM); const float* PM = (const float*)(ws + OFF_PM);
  const int lane = threadIdx.x & 63, wave = threadIdx.x >> 6, ib = wave >> 1, jb = wave & 1, r = lane & 31, g = lane >> 5;
  for (int bh = blockIdx.x; bh < 32; bh += gridDim.x) {
    float av[32];
    {
      const float* s0 = HM + ((size_t)(bh * CH_C) * 64 + 32 * ib + r) * 64 + g;
#pragma unroll
      for (int kk = 0; kk < 32; ++kk) av[kk] = s0[2 * kk];
    }
#pragma unroll 1
    for (int c = 1; c <= CH_C - 2; ++c) {
      const float* pb = PM + ((size_t)(bh * CH_C + c) * 64 + g) * 64 + 32 * jb + r;
      float* hb = HM + ((size_t)(bh * CH_C + c) * 64 + 32 * ib + 4 * g) * 64 + 32 * jb + r;
      f32x16 acc;
#pragma unroll
      for (int q = 0; q < 16; ++q) acc[q] = hb[(size_t)((q & 3) + 8 * (q >> 2)) * 64];
      float bv[32];
#pragma unroll
      for (int kk = 0; kk < 32; ++kk) bv[kk] = pb[(size_t)(2 * kk) * 64];
#pragma unroll
      for (int kk = 0; kk < 32; ++kk) acc = __builtin_amdgcn_mfma_f32_32x32x2f32(av[kk], bv[kk], acc, 0, 0, 0);
      const int j = 32 * jb + r;
      __syncthreads();
#pragma unroll
      for (int q = 0; q < 16; ++q) {
        const int il = (q & 3) + 8 * (q >> 2) + 4 * g;
        hb[(size_t)((q & 3) + 8 * (q >> 2)) * 64] = acc[q];
        sA[(32 * ib + il) * SLD + (j & 1) * 32 + (j >> 1)] = acc[q];
      }
      __syncthreads();
#pragma unroll
      for (int k4 = 0; k4 < 8; ++k4) {
        const float4 v = *(const float4*)(sA + (32 * ib + r) * SLD + g * 32 + 4 * k4);
        av[4 * k4] = v.x; av[4 * k4 + 1] = v.y; av[4 * k4 + 2] = v.z; av[4 * k4 + 3] = v.w;
      }
    }
  }
}
DI void phase_scan3(const Params& P, char* smem) {
  const int lane = threadIdx.x & 63;
  const int wave = __builtin_amdgcn_readfirstlane((int)(threadIdx.x >> 6));
  float* lds = (float*)smem + wave * SC_WLDS;
  const int nitems = 32 * CH_C;
  for (int it = blockIdx.x * 4 + wave; it < nitems; it += gridDim.x * 4) scan_chunk<2>(P, it / CH_C, it % CH_C, lane, lds);
}

DI void phase_outproj(const Params& P, char* smem) {
  u16* sW = (u16*)smem; u16* sX = sW + 128 * LDS_LD;
  char* ws = P.ws;
  const u16* Wt = (const u16*)(ws + OFF_WOUTT); const u16* CAT = (const u16*)(ws + OFF_ACT);
  const int lane = threadIdx.x & 63, wave = threadIdx.x >> 6, wn = wave >> 1, wm = wave & 1, r = lane & 31, h = lane >> 5;
  constexpr int NT = 8, MT = 256;
  for (int tile = blockIdx.x; tile < NT * MT; tile += gridDim.x) {
    int mt = tile / NT, nt = tile % NT;
    f32x16 acc[2][2]; zero_acc(acc);
    gemm_tile(acc, Wt + (size_t)nt * 128 * 1024, 1024, CAT + (size_t)mt * 128 * 1024, 1024, 1024, sW, sX);
#pragma unroll
    for (int ai = 0; ai < 2; ++ai)
#pragma unroll
      for (int bi = 0; bi < 2; ++bi) {
        const int nb = nt * 128 + wn * 64 + ai * 32;
        const size_t m = mt * 128 + wm * 64 + bi * 32 + r;
#pragma unroll
        for (int q = 0; q < 4; ++q) {
          const int n = nb + 8 * q + 4 * h;
          float4 xv = *(const float4*)(P.x + m * 1024 + n);
          *(float4*)(P.out + m * 1024 + n) = make_float4(xv.x + acc[ai][bi][4 * q], xv.y + acc[ai][bi][4 * q + 1], xv.z + acc[ai][bi][4 * q + 2], xv.w + acc[ai][bi][4 * q + 3]);
        }
      }
  }
}

DI void phase_qproj(const Params& P, char* smem, int half) {
  u16* sW = (u16*)smem; u16* sX = sW + 128 * LDS_LD;
  char* ws = P.ws;
  const u16* Wt = (const u16*)(ws + OFF_WQT); const u16* A = (const u16*)(ws + OFF_ACT); u16* Q16 = (u16*)(ws + OFF_Q16);
  const int lane = threadIdx.x & 63, wave = threadIdx.x >> 6, wn = wave >> 1, wm = wave & 1, r = lane & 31, h = lane >> 5;
  constexpr int NT = 16, MT = 128;
  for (int tile = blockIdx.x; tile < NT * MT; tile += gridDim.x) {
    int mt = tile / NT, nt = tile % NT;
    f32x16 acc[2][2]; zero_acc(acc);
    gemm_tile(acc, Wt + (size_t)nt * 128 * 1024, 1024, A + (size_t)(half * 128 + mt) * 128 * 1024, 1024, 1024, sW, sX);
#pragma unroll
    for (int ai = 0; ai < 2; ++ai)
#pragma unroll
      for (int bi = 0; bi < 2; ++bi) {
        const int nb = nt * 128 + wn * 64 + ai * 32;
        const size_t m = mt * 128 + wm * 64 + bi * 32 + r;
#pragma unroll
        for (int q = 0; q < 4; ++q) {
          u32x2 pk = {pack2(acc[ai][bi][4 * q], acc[ai][bi][4 * q + 1]), pack2(acc[ai][bi][4 * q + 2], acc[ai][bi][4 * q + 3])};
          *(u32x2*)(Q16 + m * 2048 + nb + 8 * q + 4 * h) = pk;
        }
      }
  }
}
DI void phase_scores(const Params& P, char* smem) {
  u16* sW = (u16*)smem; u16* sX = sW + 128 * LDS_LD;
  char* ws = P.ws;
  const u16* SK = (const u16*)(ws + OFF_SUBK); const u16* Q16 = (const u16*)(ws + OFF_Q16); float* ST = (float*)(ws + OFF_ST);
  const int lane = threadIdx.x & 63, wave = threadIdx.x >> 6, wn = wave >> 1, wm = wave & 1, r = lane & 31, h = lane >> 5;
  for (int tile = blockIdx.x; tile < 16 * 128; tile += gridDim.x) {
    int mt = tile >> 4, hp = tile & 15;
    f32x16 acc[2][2]; zero_acc(acc);
    gemm_tile(acc, SK + (size_t)hp * 128 * 128, 128, Q16 + (size_t)mt * 128 * 2048 + hp * 128, 2048, 128, sW, sX);
#pragma unroll
    for (int ai = 0; ai < 2; ++ai)
#pragma unroll
      for (int bi = 0; bi < 2; ++bi) {
        const int nb = wn * 64 + ai * 32;
        const size_t m = mt * 128 + wm * 64 + bi * 32 + r;
#pragma unroll
        for (int i = 0; i < 16; ++i) ST[((size_t)(hp * 128 + nb + crow(i, h))) * TH_ + m] = acc[ai][bi][i];
      }
  }
}
DI u32 ford(float f) { u32 u = __float_as_uint(f); return u ^ ((u32)((int)u >> 31) | 0x80000000u); }
DI float funord(u32 k) { u32 u = (k & 0x80000000u) ? (k ^ 0x80000000u) : ~k; return __uint_as_float(u); }
DI void ins16(u32 (&L)[16], u32 x) {
#pragma unroll
  for (int k = 0; k < 16; ++k) { u32 hi = max(L[k], x); x = min(L[k], x); L[k] = hi; }
}
DI void phase_topk(const Params& P, int half) {
  char* ws = P.ws;
  const float* ST = (const float*)(ws + OFF_ST); int* IDX = (int*)(ws + OFF_IDX); float* GATE = (float*)(ws + OFF_GATE);
  const int lane = threadIdx.x & 63, wave = threadIdx.x >> 6;
  for (int it = blockIdx.x * 4 + wave; it < (TH_ / 64) * 8; it += gridDim.x * 4) {
    const int hd = it & 7, tl = (it >> 3) * 64 + lane, t = half * TH_ + tl;
    u32 L1[16], L2[16];
#pragma unroll
    for (int k = 0; k < 16; ++k) { L1[k] = 0u; L2[k] = 0u; }
    const float* s1 = ST + ((size_t)(hd * 2) * 128) * TH_ + tl;
    const float* s2 = ST + ((size_t)(hd * 2 + 1) * 128) * TH_ + tl;
#pragma unroll 8
    for (int n = 0; n < 128; ++n) {
      ins16(L1, (ford(s1[(size_t)n * TH_]) & ~127u) | (u32)(127 - n));
      ins16(L2, (ford(s2[(size_t)n * TH_]) & ~127u) | (u32)(127 - n));
    }
    float v1[16], v2[16];
#pragma unroll
    for (int k = 0; k < 16; ++k) { v1[k] = funord(L1[k] & ~127u); v2[k] = funord(L2[k] & ~127u); }
    u32 C[16];
#pragma unroll
    for (int k = 0; k < 16; ++k) C[k] = 0u;
#pragma unroll
    for (int a = 0; a < 16; ++a)
#pragma unroll
      for (int bb = 0; bb < 16; ++bb)
        if ((a + 1) * (bb + 1) <= 16) ins16(C, (ford(v1[a] + v2[bb]) & ~255u) | (u32)(255 - (a * 16 + bb)));
    float best[16]; float den = 0.f;
    const float m0 = funord(C[0] & ~255u);
#pragma unroll
    for (int k = 0; k < 16; ++k) { best[k] = __expf(funord(C[k] & ~255u) - m0); den += best[k]; }
    const float rden = 1.f / den;
#pragma unroll
    for (int k4 = 0; k4 < 4; ++k4) {
      int id[4];
#pragma unroll
      for (int u = 0; u < 4; ++u) {
        const int k = k4 * 4 + u;
        const int ab = 255 - (int)(C[k] & 255u), a = ab >> 4, bb = ab & 15;
        u32 e1 = 0, e2 = 0;
#pragma unroll
        for (int q = 0; q < 16; ++q) { e1 = (a == q) ? L1[q] : e1; e2 = (bb == q) ? L2[q] : e2; }
        id[u] = (127 - (int)(e1 & 127u)) * 128 + (127 - (int)(e2 & 127u));
      }
      *(int4*)(IDX + (size_t)t * 128 + hd * 16 + k4 * 4) = make_int4(id[0], id[1], id[2], id[3]);
      *(float4*)(GATE + (size_t)t * 128 + hd * 16 + k4 * 4) = make_float4(best[k4 * 4] * rden, best[k4 * 4 + 1] * rden, best[k4 * 4 + 2] * rden, best[k4 * 4 + 3] * rden);
    }
  }
}
DI float gelu_(float x) { return 0.5f * x * (1.f + erff(x * 0.70710678118654752f)); }
DI void fp8x16_to_f32(u32x4 v, float (&f)[16]) {
  const u32 w[4] = {v.x, v.y, v.z, v.w};
#pragma unroll
  for (int k = 0; k < 4; ++k) {
    f32x2 lo = __builtin_amdgcn_cvt_pk_f32_fp8((int)w[k], false), hi = __builtin_amdgcn_cvt_pk_f32_fp8((int)w[k], true);
    f[4 * k] = lo.x; f[4 * k + 1] = lo.y; f[4 * k + 2] = hi.x; f[4 * k + 3] = hi.y;
  }
}
DI void phase_gather(const Params& P) {
  char* ws = P.ws;
  const int* IDX = (const int*)(ws + OFF_IDX); const float* GATE = (const float*)(ws + OFF_GATE);
  const unsigned char* PU = (const unsigned char*)(ws + OFF_PU16); const unsigned char* PV = (const unsigned char*)(ws + OFF_PV16);
  u16* ACT = (u16*)(ws + OFF_ACT);
  const int lane = threadIdx.x & 63, wave = threadIdx.x >> 6;
  for (int t = blockIdx.x * 4 + wave; t < T_; t += gridDim.x * 4) {
    const u16* xr = ACT + (size_t)t * 1024 + lane * 16;
    float xf[16];
    {
      const u32x4 x0 = *(const u32x4*)xr, x1 = *(const u32x4*)(xr + 8);
      xf[0] = bflo(x0.x); xf[1] = bfhi(x0.x); xf[2] = bflo(x0.y); xf[3] = bfhi(x0.y); xf[4] = bflo(x0.z); xf[5] = bfhi(x0.z); xf[6] = bflo(x0.w); xf[7] = bfhi(x0.w);
      xf[8] = bflo(x1.x); xf[9] = bfhi(x1.x); xf[10] = bflo(x1.y); xf[11] = bfhi(x1.y); xf[12] = bflo(x1.z); xf[13] = bfhi(x1.z); xf[14] = bflo(x1.w); xf[15] = bfhi(x1.w);
    }
    int id[2]; float gt[2];
    id[0] = IDX[(size_t)t * 128 + lane]; id[1] = IDX[(size_t)t * 128 + 64 + lane];
    gt[0] = GATE[(size_t)t * 128 + lane]; gt[1] = GATE[(size_t)t * 128 + 64 + lane];
    float acc[16];
#pragma unroll
    for (int k = 0; k < 16; ++k) acc[k] = 0.f;
#pragma unroll
    for (int hf = 0; hf < 2; ++hf) {
#pragma unroll 1
      for (int hq = 0; hq < 4; ++hq) {
        u32x4 rec[16];
#pragma unroll
        for (int j = 0; j < 16; ++j) {
          const int row = __builtin_amdgcn_readlane(id[hf], hq * 16 + j);
          rec[j] = *(const u32x4*)(PU + (size_t)row * 1024 + lane * 16);
        }
        float dsel = 0.f;
        const int li = lane & 15;
#pragma unroll
        for (int j = 0; j < 16; ++j) {
          float uf[16]; fp4x8_to_f32(rec[j].x, uf); fp4x8_to_f32(rec[j].y, uf + 8);
          float p0 = 0.f, p1 = 0.f;
#pragma unroll
          for (int k = 0; k < 16; k += 2) { p0 = fmaf(uf[k], xf[k], p0); p1 = fmaf(uf[k + 1], xf[k + 1], p1); }
          float rs = sum8(p0 + p1); rs += dppf<0x140>(rs);
          dsel = (li == j) ? rs : dsel;
        }
        dsel += __shfl_xor(dsel, 16);
        dsel += __shfl_xor(dsel, 32);
        const float wsel = 0.1f * gt[hf] * gelu_(dsel * 0.015625f);
#pragma unroll
        for (int j = 0; j < 16; ++j) {
          const float w = rlf(wsel, hq * 16 + j);
          float vf[16]; fp4x8_to_f32(rec[j].z, vf); fp4x8_to_f32(rec[j].w, vf + 8);
#pragma unroll
          for (int k = 0; k < 16; ++k) acc[k] = fmaf(w, vf[k], acc[k]);
        }
      }
    }
    float* hr = P.out + (size_t)t * 1024 + lane * 16;
    float ss = 0.f;
#pragma unroll
    for (int q = 0; q < 4; ++q) {
      float4 hv = *(const float4*)(hr + 4 * q);
      hv.x += acc[4 * q]; hv.y += acc[4 * q + 1]; hv.z += acc[4 * q + 2]; hv.w += acc[4 * q + 3];
      *(float4*)(hr + 4 * q) = hv;
      acc[4 * q] = hv.x; acc[4 * q + 1] = hv.y; acc[4 * q + 2] = hv.z; acc[4 * q + 3] = hv.w;
      ss += hv.x * hv.x + hv.y * hv.y + hv.z * hv.z + hv.w * hv.w;
    }
    ss = wave_sum(ss);
    const float rs = rsqrtf(ss * (1.f / 1024.f) + 1e-6f);
    const float* g = P.norm_ple_g + lane * 16;
    u32 o[8];
#pragma unroll
    for (int q = 0; q < 4; ++q) {
      float4 gg = *(const float4*)(g + 4 * q);
      o[2 * q] = pack2(acc[4 * q] * rs * gg.x, acc[4 * q + 1] * rs * gg.y); o[2 * q + 1] = pack2(acc[4 * q + 2] * rs * gg.z, acc[4 * q + 3] * rs * gg.w);
    }
    u32x4 o0 = {o[0], o[1], o[2], o[3]}, o1 = {o[4], o[5], o[6], o[7]};
    *(u32x4*)(ACT + (size_t)t * 1024 + lane * 16) = o0; *(u32x4*)(ACT + (size_t)t * 1024 + lane * 16 + 8) = o1;
  }
}
DI void phase_ple(const Params& P, char* smem) {
  u16* sW = (u16*)smem; u16* sX = sW + 128 * LDS_LD;
  char* ws = P.ws;
  const u16* WgT = (const u16*)(ws + OFF_WGT); const u16* WpT = (const u16*)(ws + OFF_WPT);
  const u16* A = (const u16*)(ws + OFF_ACT); const u16* P16 = (const u16*)(ws + OFF_P16);
  const int lane = threadIdx.x & 63, wave = threadIdx.x >> 6, wn = wave >> 1, wm = wave & 1, r = lane & 31, h = lane >> 5;
  constexpr int NT = 8, MT = 256;
  for (int tile = blockIdx.x; tile < NT * MT; tile += gridDim.x) {
    int mt = tile / NT, nt = tile % NT;
    f32x16 acc[2][2], acc2[2][2]; zero_acc(acc); zero_acc(acc2);
    gemm_tile(acc, WgT + (size_t)nt * 128 * 1024, 1024, A + (size_t)mt * 128 * 1024, 1024, 1024, sW, sX);
    gemm_tile(acc2, WpT + (size_t)nt * 128 * 256, 256, P16 + (size_t)mt * 128 * 256, 256, 256, sW, sX);
#pragma unroll
    for (int ai = 0; ai < 2; ++ai)
#pragma unroll
      for (int bi = 0; bi < 2; ++bi) {
        const int nb = nt * 128 + wn * 64 + ai * 32;
        const size_t m = mt * 128 + wm * 64 + bi * 32 + r;
#pragma unroll
        for (int q = 0; q < 4; ++q) {
          const int n = nb + 8 * q + 4 * h;
          float4 hv = *(const float4*)(P.out + m * 1024 + n);
          hv.x += sigmoidf_(acc[ai][bi][4 * q]) * acc2[ai][bi][4 * q];
          hv.y += sigmoidf_(acc[ai][bi][4 * q + 1]) * acc2[ai][bi][4 * q + 1];
          hv.z += sigmoidf_(acc[ai][bi][4 * q + 2]) * acc2[ai][bi][4 * q + 2];
          hv.w += sigmoidf_(acc[ai][bi][4 * q + 3]) * acc2[ai][bi][4 * q + 3];
          *(float4*)(P.out + m * 1024 + n) = hv;
        }
      }
  }
}
DI void phase_final(const Params& P) {
  const int lane = threadIdx.x & 63, wave = threadIdx.x >> 6;
  for (int t = blockIdx.x * 4 + wave; t < T_; t += gridDim.x * 4) {
    float4* row = (float4*)(P.out + (size_t)t * 1024);
    float4 v[4]; float ss = 0.f;
#pragma unroll
    for (int i = 0; i < 4; ++i) { v[i] = row[lane + 64 * i]; ss += v[i].x * v[i].x + v[i].y * v[i].y + v[i].z * v[i].z + v[i].w * v[i].w; }
    ss = wave_sum(ss);
    const float rs = rsqrtf(ss * (1.f / 1024.f) + 1e-6f);
#pragma unroll
    for (int i = 0; i < 4; ++i) {
      float4 g = ((const float4*)P.norm_final_g)[lane + 64 * i];
      row[lane + 64 * i] = make_float4(v[i].x * rs * g.x, v[i].y * rs * g.y, v[i].z * rs * g.z, v[i].w * rs * g.w);
    }
  }
}

#ifndef PH_MASK
#define PH_MASK 0xFFFFFFFFu
#endif
#define PH(n) if ((PH_MASK >> (n)) & 1u)
#define XB_TMO      128
#define XB_XCNT(j)  (256  + 64 * (j))
#define XB_XSUB(j)  (1280 + 64 * (j))
#define XB_XGEN(j)  (2304 + 64 * (j))
#define XB_TOP      3328
#define XB_TOPGEN   3392
#define XCD_BAR_WORDS 3456
#define XB_SPIN_CAP (1u << 18)
#define LAS __attribute__((address_space(3)))

__device__ __forceinline__ unsigned xb_ld(unsigned* p)              { return __hip_atomic_load(p, __ATOMIC_RELAXED, __HIP_MEMORY_SCOPE_AGENT); }
__device__ __forceinline__ unsigned xb_add(unsigned* p, unsigned v) { return __hip_atomic_fetch_add(p, v, __ATOMIC_RELAXED, __HIP_MEMORY_SCOPE_AGENT); }
__device__ __forceinline__ unsigned xb_xcc_id() { return (unsigned)__builtin_amdgcn_s_getreg((3 << 11) | 20) & 0xFu; }
#define XB_SPIN(cond, bar) do { unsigned _sp = 0; while (cond) { __builtin_amdgcn_s_sleep(1); \
    if ((++_sp & 255u) == 0u) { if (xb_ld(&(bar)[XB_TMO])) break; if (_sp > XB_SPIN_CAP) { atomicAdd(&(bar)[XB_TMO], 1u); break; } } } } while (0)

struct XcdBarrier {
    unsigned* bar; unsigned x;
    volatile LAS unsigned* st;
};

__device__ __forceinline__ XcdBarrier xcd_barrier_post(unsigned* bar, volatile LAS unsigned* st) {
    XcdBarrier b; b.bar = bar; b.x = xb_xcc_id(); b.st = st;
    if (threadIdx.x == 0) (void)xb_add(&bar[XB_XCNT(b.x)], 1u);
    return b;
}
__device__ __forceinline__ void xcd_barrier_complete(unsigned* bar, unsigned x, unsigned& nloc, unsigned& nx) {
    const unsigned G = gridDim.x * gridDim.y * gridDim.z;
    unsigned sum, cnt, mine, sp = 0u;
    for (;;) {
        sum = 0u; cnt = 0u; mine = 0u;
#pragma unroll
        for (unsigned j = 0; j < 16; ++j) { const unsigned c = xb_ld(&bar[XB_XCNT(j)]); sum += c; cnt += (c > 0u) ? 1u : 0u; mine = (j == x) ? c : mine; }
        if (sum == G) break;
        __builtin_amdgcn_s_sleep(1);
        if ((++sp & 255u) == 0u) { if (xb_ld(&bar[XB_TMO])) break; if (sp > XB_SPIN_CAP) { atomicAdd(&bar[XB_TMO], 1u); break; } }
    }
    nloc = mine > 0u ? mine : 1u; nx = cnt > 0u ? cnt : 1u;
}

__device__ __forceinline__ void xcd_barrier(const XcdBarrier& b) {
    asm volatile("s_waitcnt vmcnt(0)" ::: "memory");
    __syncthreads();
    if (threadIdx.x == 0) {
        unsigned* bar = b.bar;
        __builtin_amdgcn_s_waitcnt(0);
        unsigned nloc = b.st[0], nx = b.st[1];
        if (nloc == 0u) { xcd_barrier_complete(bar, b.x, nloc, nx); b.st[0] = nloc; b.st[1] = nx; }
        const unsigned old = xb_add(&bar[XB_XSUB(b.x)], 1u);
        const unsigned gen = old / nloc;
        if (old + 1u == (gen + 1u) * nloc) {
            __builtin_amdgcn_fence(__ATOMIC_RELEASE, "agent");
            asm volatile("s_waitcnt vmcnt(0)" ::: "memory");
            const unsigned og = xb_add(&bar[XB_TOP], 1u);
            const unsigned tg = og / nx;
            if (og + 1u == (tg + 1u) * nx) xb_add(&bar[XB_TOPGEN], 1u);
            else XB_SPIN(xb_ld(&bar[XB_TOPGEN]) == tg, bar);
            __builtin_amdgcn_fence(__ATOMIC_ACQUIRE, "agent");
            xb_add(&bar[XB_XGEN(b.x)], 1u);
            asm volatile("s_waitcnt vmcnt(0)" ::: "memory");
        } else {
            XB_SPIN(xb_ld(&bar[XB_XGEN(b.x)]) == gen, bar);
            __builtin_amdgcn_fence(__ATOMIC_ACQUIRE, "agent");
            asm volatile("s_waitcnt vmcnt(0)" ::: "memory");
        }
    }
    __syncthreads();
}

constexpr int SMEM_BYTES = 2 * 2 * 128 * LDS_LD * 2;

__global__ void __launch_bounds__(256, 2) mega(Params P) {
  __shared__ __attribute__((aligned(16))) char smem[SMEM_BYTES];
  cg::grid_group grid = cg::this_grid();
  __shared__ __attribute__((aligned(16))) unsigned xb_st[4];
  if (threadIdx.x < 4) xb_st[threadIdx.x] = 0u;
  __syncthreads();
  XcdBarrier xb = xcd_barrier_post((unsigned*)(P.ws + OFF_CTR + 4096), (volatile LAS unsigned*)xb_st);
#define RUN(n, ...) PH(n) { if (P.ph_lo <= (n) && (n) <= P.ph_hi) { __VA_ARGS__; } } if (P.ph_lo <= (n) && (n) < P.ph_hi) { if ((n) == 0) grid.sync(); else xcd_barrier(xb); }
  RUN(0, phase_prep(P, smem))
  RUN(1, phase_gemm1(P, smem))
  RUN(2, phase_attn(P, smem); phase_rwprep(P))
  RUN(4, phase_lora(P, smem))
  RUN(5, phase_scan1(P, smem))
  RUN(6, phase_scan2(P, smem))
  RUN(7, phase_scan3(P, smem))
  RUN(8, phase_outproj(P, smem); convert_flat(P.p, (u16*)(P.ws + OFF_P16), (size_t)T_ * 256);
         convert_uv_fp4(P.peer_u, P.peer_v, (unsigned char*)(P.ws + OFF_PU16), 64.f, 10.f))
  RUN(9, rmsnorm_rows(P.out, P.norm_ffn_g, (u16*)(P.ws + OFF_ACT)))
  RUN(10, phase_qproj(P, smem, 0))
  RUN(11, phase_scores(P, smem))
  RUN(12, phase_qproj(P, smem, 1); phase_topk(P, 0))
  RUN(14, phase_scores(P, smem))
  RUN(15, phase_topk(P, 1))
  RUN(16, phase_gather(P))
  RUN(17, phase_ple(P, smem))
  RUN(18, phase_final(P))
}

extern "C" void kernel_launch(void* const* d_in, const int* in_sizes, int n_in, void* d_out, int out_size, void* d_ws, size_t ws_size,
                              hipStream_t stream) {
  static int grid_blocks = 0;
  if (!grid_blocks) {
    int dev = 0, cus = 0, per_cu = 0;
    hipGetDevice(&dev);
    hipDeviceGetAttribute(&cus, hipDeviceAttributeMultiprocessorCount, dev);
    hipOccupancyMaxActiveBlocksPerMultiprocessor(&per_cu, mega, 256, 0);
    if (per_cu < 1) per_cu = 1;
    if (per_cu > 2) per_cu = 2;
    grid_blocks = cus * per_cu;
  }
  Params P{};
  const float* const* fi = (const float* const*)d_in;
  P.x = fi[0]; P.p = fi[1]; P.pos = (const int*)d_in[2];
  P.norm_mix_g = fi[3]; P.w_in = fi[4]; P.lam_q1 = fi[5]; P.lam_k1 = fi[6]; P.lam_q2 = fi[7]; P.lam_k2 = fi[8]; P.subln_g = fi[9];
  P.rw_mu = fi[10]; P.rw_w0 = fi[11]; P.rw_w_up = fi[12]; P.rw_a0 = fi[13]; P.rw_a_up = fi[14]; P.rw_g_up = fi[15];
  P.rw_k_k = fi[16]; P.rw_k_a = fi[17]; P.rw_r_k = fi[18]; P.rw_ln_g = fi[19]; P.rw_ln_b = fi[20];
  P.w_out = fi[21]; P.norm_ffn_g = fi[22]; P.peer_w_q = fi[23]; P.peer_sub_keys = fi[24]; P.peer_u = fi[25]; P.peer_v = fi[26];
  P.norm_ple_g = fi[27]; P.ple_gate_w = fi[28]; P.ple_proj_w = fi[29]; P.norm_final_g = fi[30];
  P.out = (float*)d_out; P.ws = (char*)d_ws;
  for (int i = 0; i < 8; ++i) P.inv_freq[i] = (float)pow(500000.0, -(double)i / 8.0);
  hipMemsetAsync((char*)d_ws + OFF_CTR, 0, 32768, stream);
#ifndef ONE_LAUNCH
  for (int ph = 0; ph < 19; ++ph) {
    P.ph_lo = ph; P.ph_hi = ph;
    hipLaunchKernelGGL(mega, dim3(grid_blocks), dim3(256), 0, stream, P);
  }
#else
  P.ph_lo = 0; P.ph_hi = 18;
  void* args[] = {&P};
  hipLaunchCooperativeKernel((void*)mega, dim3(grid_blocks), dim3(256), args, 0, stream);
#endif
}
```

```cpp
#include <hip/hip_runtime.h>
#include <hip/hip_cooperative_groups.h>
#include <stdint.h>
#include <math.h>
namespace cg = cooperative_groups;

#define DI __device__ __forceinline__
#define ONE_LAUNCH 1
typedef unsigned short u16;
typedef unsigned int u32;
typedef __attribute__((ext_vector_type(4))) unsigned u32x4;
typedef __attribute__((ext_vector_type(2))) unsigned u32x2;
typedef __attribute__((ext_vector_type(8))) short bf16x8;
typedef __attribute__((ext_vector_type(4))) short s16x4;
typedef __attribute__((ext_vector_type(16))) float f32x16;
typedef __attribute__((ext_vector_type(2))) float f32x2;
typedef __attribute__((ext_vector_type(4))) float f32x4;
typedef __attribute__((ext_vector_type(2))) __bf16 bf16x2;
typedef const float __attribute__((address_space(4)))* cfptr;

constexpr int T_ = 32768, S_ = 8192, TH_ = 16384;
constexpr int CH_L = 128;
constexpr int CH_C = S_ / CH_L;
constexpr int NPHASE = 17;

constexpr size_t MiB = 1u << 20;
constexpr size_t OFF_WINT = 0;
constexpr size_t OFF_WOUTT = 7 * MiB;
constexpr size_t OFF_WQT = 9 * MiB;
constexpr size_t OFF_WGT = 13 * MiB;
constexpr size_t OFF_WPT = 15 * MiB;
constexpr size_t OFF_WLT = 15 * MiB + 512 * 1024;
constexpr size_t OFF_SUBK = 16 * MiB + 512 * 1024;
constexpr size_t OFF_ROPE = 17 * MiB;
constexpr size_t OFF_CTR = 19 * MiB;
constexpr size_t OFF_ACT = 20 * MiB;
constexpr size_t OFF_QK = 84 * MiB;
constexpr size_t OFF_VT = 148 * MiB;
constexpr size_t OFF_ZRW = 180 * MiB;
constexpr size_t OFF_V = 292 * MiB;
constexpr size_t OFF_AL = 356 * MiB;
constexpr size_t OFF_DD = 420 * MiB;
constexpr size_t OFF_L16 = 388 * MiB;
constexpr size_t OFF_PM = 100 * MiB;
constexpr size_t OFF_HM = 132 * MiB;
constexpr size_t OFF_BE = 180 * MiB;
constexpr size_t OFF_G16 = 244 * MiB;
constexpr size_t OFF_Q16 = 84 * MiB;
constexpr size_t OFF_ST = 148 * MiB;
constexpr size_t OFF_IDX = 276 * MiB;
constexpr size_t OFF_GATE = 292 * MiB;
constexpr size_t OFF_PU16 = 308 * MiB;
constexpr size_t OFF_PV16 = 340 * MiB;
constexpr size_t OFF_P16 = 468 * MiB;

struct Params {
  const float *x, *p; const int* pos;
  const float *norm_mix_g, *w_in, *lam_q1, *lam_k1, *lam_q2, *lam_k2, *subln_g;
  const float *rw_mu, *rw_w0, *rw_w_up, *rw_a0, *rw_a_up, *rw_g_up, *rw_k_k, *rw_k_a, *rw_r_k, *rw_ln_g, *rw_ln_b;
  const float *w_out, *norm_ffn_g, *peer_w_q, *peer_sub_keys, *peer_u, *peer_v, *norm_ple_g, *ple_gate_w, *ple_proj_w, *norm_final_g;
  float* out; char* ws;
  float inv_freq[8];
  int ph_lo, ph_hi;
};

DI u32 pack2(float a, float b) { f32x2 v = {a, b}; bf16x2 r = __builtin_convertvector(v, bf16x2); return __builtin_bit_cast(u32, r); }
DI u16 f2bf(float a) { return (u16)(pack2(a, 0.f) & 0xffffu); }
DI float bflo(u32 v) { return __uint_as_float(v << 16); }
DI float bfhi(u32 v) { return __uint_as_float(v & 0xffff0000u); }
DI f32x16 mfma32(bf16x8 a, bf16x8 b, f32x16 c) { return __builtin_amdgcn_mfma_f32_32x32x16_bf16(a, b, c, 0, 0, 0); }
DI int crow(int i, int h) { return (i & 3) + 8 * (i >> 2) + 4 * h; }
template <int CTRL> DI float dppf(float x) { return __int_as_float(__builtin_amdgcn_update_dpp(0, __float_as_int(x), CTRL, 0xf, 0xf, false)); }
DI float sum8(float x) { x += dppf<0xB1>(x); x += dppf<0x4E>(x); x += dppf<0x141>(x); return x; }
DI float rlf(float x, int l) { return __int_as_float(__builtin_amdgcn_readlane(__float_as_int(x), l)); }
DI float wave_sum(float x) {
  x = sum8(x); x += dppf<0x140>(x);
  return (rlf(x, 0) + rlf(x, 16)) + (rlf(x, 32) + rlf(x, 48));
}
DI float xor32(float x) { return __shfl_xor(x, 32); }
DI cfptr to_const(const float* p) { return (cfptr)(uintptr_t)p; }
DI float sigmoidf_(float x) { return 1.f / (1.f + __expf(-x)); }
DI float dot8(u32x4 a, u32x4 b, float acc) {
  acc = fmaf(bflo(a.x), bflo(b.x), acc); acc = fmaf(bfhi(a.x), bfhi(b.x), acc);
  acc = fmaf(bflo(a.y), bflo(b.y), acc); acc = fmaf(bfhi(a.y), bfhi(b.y), acc);
  acc = fmaf(bflo(a.z), bflo(b.z), acc); acc = fmaf(bfhi(a.z), bfhi(b.z), acc);
  acc = fmaf(bflo(a.w), bflo(b.w), acc); acc = fmaf(bfhi(a.w), bfhi(b.w), acc);
  return acc;
}

constexpr int LDS_LD = 72;
constexpr int G_BUF = 2 * 128 * LDS_LD;
DI void gemm_tile(f32x16 (&acc)[2][2], const u16* Wt, int ldw, const u16* X, int ldx, int K, u16* sW, u16* sX) {
  const int tid = threadIdx.x, lane = tid & 63, wave = tid >> 6;
  const int wn = wave >> 1, wm = wave & 1, r = lane & 31, h = lane >> 5;
  const u16* gw = Wt + (size_t)(tid >> 3) * ldw + (tid & 7) * 8;
  const u16* gx = X + (size_t)(tid >> 3) * ldx + (tid & 7) * 8;
  u16* lw = sW + (tid >> 3) * LDS_LD + (tid & 7) * 8;
  u16* lx = sX + (tid >> 3) * LDS_LD + (tid & 7) * 8;
  const size_t sw32 = (size_t)32 * ldw, sx32 = (size_t)32 * ldx;
  const u16* pa = sW + (wn * 64 + r) * LDS_LD + h * 8;
  const u16* pb = sX + (wm * 64 + r) * LDS_LD + h * 8;
  const int nk = K >> 6;
  u32x4 r0w[4], r0x[4], r1w[4], r1x[4];
#define G_LOAD(RW, RX, kt) { _Pragma("unroll") for (int i = 0; i < 4; ++i) { RW[i] = *(const u32x4*)(gw + i * sw32 + (kt) * 64); RX[i] = *(const u32x4*)(gx + i * sx32 + (kt) * 64); } }
#define G_STORE(RW, RX, st) { _Pragma("unroll") for (int i = 0; i < 4; ++i) { *(u32x4*)(lw + (st) * G_BUF + i * 32 * LDS_LD) = RW[i]; *(u32x4*)(lx + (st) * G_BUF + i * 32 * LDS_LD) = RX[i]; } }
#define G_COMPUTE(st) { _Pragma("unroll") for (int ks = 0; ks < 4; ++ks) { bf16x8 a[2], b[2]; \
    _Pragma("unroll") for (int i = 0; i < 2; ++i) { a[i] = *(const bf16x8*)(pa + (st) * G_BUF + i * 32 * LDS_LD + ks * 16); b[i] = *(const bf16x8*)(pb + (st) * G_BUF + i * 32 * LDS_LD + ks * 16); } \
    _Pragma("unroll") for (int i = 0; i < 2; ++i) _Pragma("unroll") for (int jj = 0; jj < 2; ++jj) acc[i][jj] = mfma32(a[i], b[jj], acc[i][jj]); } }
  G_LOAD(r0w, r0x, 0)
  __syncthreads();
  G_STORE(r0w, r0x, 0)
  G_LOAD(r0w, r0x, 1)
  if (nk > 2) G_LOAD(r1w, r1x, 2)
  __syncthreads();
  for (int k = 0; k < nk; k += 2) {
    G_COMPUTE(0)
    G_STORE(r0w, r0x, 1)
    if (k + 3 < nk) G_LOAD(r0w, r0x, k + 3)
    __syncthreads();
    G_COMPUTE(1)
    if (k + 2 < nk) {
      G_STORE(r1w, r1x, 0)
      if (k + 4 < nk) G_LOAD(r1w, r1x, k + 4)
      __syncthreads();
    }
  }
#undef G_LOAD
#undef G_STORE
#undef G_COMPUTE
}
DI void zero_acc(f32x16 (&acc)[2][2]) {
#pragma unroll
  for (int i = 0; i < 2; ++i)
#pragma unroll
    for (int j = 0; j < 2; ++j)
#pragma unroll
      for (int k = 0; k < 16; ++k) acc[i][j][k] = 0.f;
}

DI void transpose_tile(const float* src, int N, int kt, int nt, u16* dst, int ldd, int kofs, bool valid, float* tile) {
  const int tid = threadIdx.x;
  if (valid) {
#pragma unroll 4
    for (int i = 0; i < 16; ++i) {
      int idx = tid + 256 * i, kk = idx >> 6, nn = idx & 63;
      tile[kk * 65 + nn] = src[(size_t)(kt * 64 + kk) * N + nt * 64 + nn];
    }
  }
  __syncthreads();
#pragma unroll 4
  for (int i = 0; i < 16; ++i) {
    int idx = tid + 256 * i, nn = idx >> 6, kk = idx & 63;
    float v = valid ? tile[kk * 65 + nn] : 0.f;
    dst[(size_t)(nt * 64 + nn) * ldd + kofs + kt * 64 + kk] = f2bf(v);
  }
  __syncthreads();
}
DI void transpose_all(const float* src, int K, int N, u16* dst, float* tile) {
  int KT = K / 64, NTt = N / 64;
  for (int t = blockIdx.x; t < KT * NTt; t += gridDim.x) transpose_tile(src, N, t % KT, t / KT, dst, K, 0, true, tile);
}
DI void convert_flat(const float* src, u16* dst, size_t n) {
  size_t n4 = n / 4;
  for (size_t i = (size_t)blockIdx.x * 256 + threadIdx.x; i < n4; i += (size_t)gridDim.x * 256) {
    float4 v = ((const float4*)src)[i];
    u32x2 o = {pack2(v.x, v.y), pack2(v.z, v.w)};
    ((u32x2*)dst)[i] = o;
  }
}
DI void convert_fp8(const float* src, unsigned char* dst, size_t n, float scale) {
  size_t n8 = n / 8;
  for (size_t i = (size_t)blockIdx.x * 256 + threadIdx.x; i < n8; i += (size_t)gridDim.x * 256) {
    float4 a = ((const float4*)src)[2 * i], b = ((const float4*)src)[2 * i + 1];
    int r0 = __builtin_amdgcn_cvt_pk_fp8_f32(a.x * scale, a.y * scale, 0, false);
    r0 = __builtin_amdgcn_cvt_pk_fp8_f32(a.z * scale, a.w * scale, r0, true);
    int r1 = __builtin_amdgcn_cvt_pk_fp8_f32(b.x * scale, b.y * scale, 0, false);
    r1 = __builtin_amdgcn_cvt_pk_fp8_f32(b.z * scale, b.w * scale, r1, true);
    u32x2 o = {(u32)r0, (u32)r1};
    ((u32x2*)dst)[i] = o;
  }
}
DI void convert_fp4(const float* src, unsigned char* dst, size_t n, float scale) {
  size_t n8 = n / 8;
  for (size_t i = (size_t)blockIdx.x * 256 + threadIdx.x; i < n8; i += (size_t)gridDim.x * 256) {
    float4 a = ((const float4*)src)[2 * i], b = ((const float4*)src)[2 * i + 1];
    u32 r = 0u;
    r = __builtin_amdgcn_cvt_scalef32_pk_fp4_f32(r, a.x * scale, a.y * scale, 1.0f, 0);
    r = __builtin_amdgcn_cvt_scalef32_pk_fp4_f32(r, a.z * scale, a.w * scale, 1.0f, 1);
    r = __builtin_amdgcn_cvt_scalef32_pk_fp4_f32(r, b.x * scale, b.y * scale, 1.0f, 2);
    r = __builtin_amdgcn_cvt_scalef32_pk_fp4_f32(r, b.z * scale, b.w * scale, 1.0f, 3);
    ((u32*)dst)[i] = r;
  }
}
DI void fp4x8_to_f32(u32 w, float* f) {
  f32x2 p0 = __builtin_amdgcn_cvt_scalef32_pk_f32_fp4(w, 1.0f, 0), p1 = __builtin_amdgcn_cvt_scalef32_pk_f32_fp4(w, 1.0f, 1);
  f32x2 p2 = __builtin_amdgcn_cvt_scalef32_pk_f32_fp4(w, 1.0f, 2), p3 = __builtin_amdgcn_cvt_scalef32_pk_f32_fp4(w, 1.0f, 3);
  f[0] = p0.x; f[1] = p0.y; f[2] = p1.x; f[3] = p1.y; f[4] = p2.x; f[5] = p2.y; f[6] = p3.x; f[7] = p3.y;
}
DI u32 pack_fp4x8(const float4 a, const float4 b, float scale) {
  u32 r = 0u;
  r = __builtin_amdgcn_cvt_scalef32_pk_fp4_f32(r, a.x * scale, a.y * scale, 1.0f, 0);
  r = __builtin_amdgcn_cvt_scalef32_pk_fp4_f32(r, a.z * scale, a.w * scale, 1.0f, 1);
  r = __builtin_amdgcn_cvt_scalef32_pk_fp4_f32(r, b.x * scale, b.y * scale, 1.0f, 2);
  r = __builtin_amdgcn_cvt_scalef32_pk_fp4_f32(r, b.z * scale, b.w * scale, 1.0f, 3);
  return r;
}
DI void convert_uv_fp4(const float* u, const float* v, unsigned char* dst, float su, float sv) {
  const size_t n = (size_t)16384 * 64;
  for (size_t i = (size_t)blockIdx.x * 256 + threadIdx.x; i < n; i += (size_t)gridDim.x * 256) {
    const float4* pu = (const float4*)(u + i * 16); const float4* pv = (const float4*)(v + i * 16);
    u32x4 o = {pack_fp4x8(pu[0], pu[1], su), pack_fp4x8(pu[2], pu[3], su), pack_fp4x8(pv[0], pv[1], sv), pack_fp4x8(pv[2], pv[3], sv)};
    ((u32x4*)dst)[i] = o;
  }
}
DI void rmsnorm_rows(const float* src, const float* g, u16* dst) {
  const int lane = threadIdx.x & 63, wave = threadIdx.x >> 6;
  for (int t = blockIdx.x * 4 + wave; t < T_; t += gridDim.x * 4) {
    const float4* row = (const float4*)(src + (size_t)t * 1024);
    float4 v[4]; float ss = 0.f;
#pragma unroll
    for (int i = 0; i < 4; ++i) { v[i] = row[lane + 64 * i]; ss += v[i].x * v[i].x + v[i].y * v[i].y + v[i].z * v[i].z + v[i].w * v[i].w; }
    ss = wave_sum(ss);
    float rs = rsqrtf(ss * (1.f / 1024.f) + 1e-6f);
#pragma unroll
    for (int i = 0; i < 4; ++i) {
      float4 gg = ((const float4*)g)[lane + 64 * i];
      u32x2 o = {pack2(v[i].x * rs * gg.x, v[i].y * rs * gg.y), pack2(v[i].z * rs * gg.z, v[i].w * rs * gg.w)};
      ((u32x2*)(dst + (size_t)t * 1024))[lane + 64 * i] = o;
    }
  }
}
DI void phase_prep(const Params& P, char* smem) {
  float* tile = (float*)smem;
  char* ws = P.ws;
  transpose_all(P.w_in, 1024, 3328, (u16*)(ws + OFF_WINT), tile);
  transpose_all(P.w_out, 1024, 1024, (u16*)(ws + OFF_WOUTT), tile);
  transpose_all(P.peer_w_q, 1024, 2048, (u16*)(ws + OFF_WQT), tile);
  transpose_all(P.ple_gate_w, 1024, 1024, (u16*)(ws + OFF_WGT), tile);
  transpose_all(P.ple_proj_w, 256, 1024, (u16*)(ws + OFF_WPT), tile);
  for (int t = blockIdx.x; t < 24 * 4; t += gridDim.x) {
    int nt = t >> 2, kt = t & 3, sec = nt >> 3, ntl = nt & 7;
    const float* src; int kts; bool valid;
    if (sec == 0) { src = P.rw_w_up; valid = (kt == 0); kts = 0; }
    else if (sec == 1) { src = P.rw_a_up; valid = (kt == 1); kts = 0; }
    else { src = P.rw_g_up; valid = (kt >= 2); kts = kt - 2; }
    transpose_tile(src, 512, kts, ntl, (u16*)(ws + OFF_WLT) + (size_t)sec * 512 * 256, 256, (kt - kts) * 64, valid, tile);
  }
  convert_flat(P.peer_sub_keys, (u16*)(ws + OFF_SUBK), (size_t)16 * 128 * 128);
  float2* rope = (float2*)(ws + OFF_ROPE);
  for (int i = blockIdx.x * 256 + threadIdx.x; i < T_ * 8; i += gridDim.x * 256) {
    int m = i >> 3, f = i & 7;
    float ang = (float)P.pos[m] * P.inv_freq[f];
    double a = (double)ang;
    double k = rint(a * 0.15915494309189535);
    float rr = (float)(a - k * 6.283185307179586);
    rope[i] = make_float2(__cosf(rr), __sinf(rr));
  }
  rmsnorm_rows(P.x, P.norm_mix_g, (u16*)(ws + OFF_ACT));
}

DI void phase_gemm1(const Params& P, char* smem) {
  u16* sW = (u16*)smem; u16* sX = sW + 128 * LDS_LD;
  char* ws = P.ws;
  const u16* WinT = (const u16*)(ws + OFF_WINT); const u16* ACT = (const u16*)(ws + OFF_ACT);
  const float2* rope = (const float2*)(ws + OFF_ROPE);
  u16* QK = (u16*)(ws + OFF_QK); u16* VT = (u16*)(ws + OFF_VT); u16* ZRW = (u16*)(ws + OFF_ZRW);
  const int lane = threadIdx.x & 63, wave = threadIdx.x >> 6, wn = wave >> 1, wm = wave & 1, r = lane & 31, h = lane >> 5;
  constexpr int NT = 26, MT = 256;
  for (int tile = blockIdx.x; tile < NT * MT; tile += gridDim.x) {
    int mt = tile / NT, nt = tile % NT;
    f32x16 acc[2][2]; zero_acc(acc);
    gemm_tile(acc, WinT + (size_t)nt * 128 * 1024, 1024, ACT + (size_t)mt * 128 * 1024, 1024, 1024, sW, sX);
#pragma unroll
    for (int ai = 0; ai < 2; ++ai)
#pragma unroll
      for (int bi = 0; bi < 2; ++bi) {
        const int nb = nt * 128 + wn * 64 + ai * 32;
        const int m = mt * 128 + wm * 64 + bi * 32 + r;
        f32x16 v = acc[ai][bi];
        if (nb < 1024) {
          if ((nb & 63) == 0) {
#pragma unroll
            for (int i = 0; i < 4; ++i) {
              float2 cs = rope[m * 8 + 4 * h + i];
              float t1 = v[i], t2 = v[i + 4];
              v[i] = t1 * cs.x - t2 * cs.y; v[i + 4] = t2 * cs.x + t1 * cs.y;
            }
          }
          if (nb < 512) {
#pragma unroll
            for (int i = 0; i < 16; ++i) v[i] *= 0.125f;
          }
#pragma unroll
          for (int q = 0; q < 4; ++q) {
            u32x2 pk = {pack2(v[4 * q], v[4 * q + 1]), pack2(v[4 * q + 2], v[4 * q + 3])};
            *(u32x2*)(QK + (size_t)m * 1024 + nb + 8 * q + 4 * h) = pk;
          }
        } else if (nb < 1536) {
          const int hh = (nb - 1024) >> 7, dv0 = (nb - 1024) & 127, b = m >> 13, s = m & 8191;
#pragma unroll
          for (int i = 0; i < 16; ++i) VT[((size_t)((b * 4 + hh) * 128 + dv0 + crow(i, h))) * S_ + s] = f2bf(v[i]);
        } else {
#pragma unroll
          for (int q = 0; q < 4; ++q) {
            u32x2 pk = {pack2(v[4 * q], v[4 * q + 1]), pack2(v[4 * q + 2], v[4 * q + 3])};
            *(u32x2*)(ZRW + (size_t)m * 1792 + (nb - 1536) + 8 * q + 4 * h) = pk;
          }
        }
      }
  }
}

DI void phase_attn(const Params& P, char* smem) {
  constexpr int ATT_BUF = (64 + 128) * LDS_LD;
  u16* sK = (u16*)smem;
  u16* sV = sK + 64 * LDS_LD;
  int* sItem = (int*)(sK + 2 * ATT_BUF);
  char* ws = P.ws;
  const u16* QK = (const u16*)(ws + OFF_QK); const u16* VT = (const u16*)(ws + OFF_VT);
  u16* CAT = (u16*)(ws + OFF_ACT);
  unsigned* ctr = (unsigned*)(ws + OFF_CTR);
  const int tid = threadIdx.x, lane = tid & 63, wave = tid >> 6, r = lane & 31, h = lane >> 5;
  float d1 = 0.f, d2 = 0.f;
  for (int i = 0; i < 64; ++i) { d1 += P.lam_q1[i] * P.lam_k1[i]; d2 += P.lam_q2[i] * P.lam_k2[i]; }
  const float lam = expf(d1) - expf(d2) + 0.2f;
  const float LOG2E = 1.4426950408889634f;
  for (;;) {
    __syncthreads();
    if (tid == 0) *sItem = (int)atomicAdd(ctr, 1u);
    __syncthreads();
    const int item = *sItem;
    if (item >= 1024) break;
    const int qt = 63 - (item >> 4), bh = item & 15, b = bh >> 2, hh = bh & 3;
    const int qlo = qt * 128 + wave * 32;
    const size_t mq = (size_t)b * S_ + qlo + r;
    const int ntiles = 2 * qt + 2;
    float4* scr = (float4*)(ws + 324 * MiB) + (size_t)blockIdx.x * 16 * 256 + tid;
#pragma unroll
    for (int c = 0; c < 2; ++c) {
      bf16x8 qf[4];
#pragma unroll
      for (int ks = 0; ks < 4; ++ks) qf[ks] = *(const bf16x8*)(QK + mq * 1024 + hh * 128 + c * 64 + ks * 16 + h * 8);
      f32x16 o[4];
#pragma unroll
      for (int d = 0; d < 4; ++d)
#pragma unroll
        for (int i = 0; i < 16; ++i) o[d][i] = 0.f;
      float mrow = -1e30f, lsum = 0.f;
      const u16* kbase = QK + ((size_t)b * S_) * 1024 + 512 + hh * 128 + c * 64;
      const u16* vbase = VT + ((size_t)(b * 4 + hh) * 128) * S_;
      u32x4 rk[2], rv[4];
#pragma unroll
      for (int i = 0; i < 2; ++i) { int cc = tid + 256 * i, row = cc >> 3, kc = cc & 7; rk[i] = *(const u32x4*)(kbase + (size_t)row * 1024 + kc * 8); }
#pragma unroll
      for (int i = 0; i < 4; ++i) { int cc = tid + 256 * i, row = cc >> 3, kc = cc & 7; rv[i] = *(const u32x4*)(vbase + (size_t)row * S_ + kc * 8); }
      __syncthreads();
#pragma unroll
      for (int i = 0; i < 2; ++i) { int cc = tid + 256 * i, row = cc >> 3, kc = cc & 7; *(u32x4*)(sK + row * LDS_LD + kc * 8) = rk[i]; }
#pragma unroll
      for (int i = 0; i < 4; ++i) { int cc = tid + 256 * i, row = cc >> 3, kc = cc & 7; *(u32x4*)(sV + row * LDS_LD + kc * 8) = rv[i]; }
      __syncthreads();
      for (int j = 0; j < ntiles; ++j) {
        const int cur = j & 1;
        const u16* sKc = sK + cur * ATT_BUF; const u16* sVc = sV + cur * ATT_BUF;
        u16* sKn = sK + (cur ^ 1) * ATT_BUF; u16* sVn = sV + (cur ^ 1) * ATT_BUF;
        const bool more = (j + 1 < ntiles);
        if (more) {
          const int k0 = (j + 1) * 64;
#pragma unroll
          for (int i = 0; i < 2; ++i) { int cc = tid + 256 * i, row = cc >> 3, kc = cc & 7; rk[i] = *(const u32x4*)(kbase + (size_t)(k0 + row) * 1024 + kc * 8); }
#pragma unroll
          for (int i = 0; i < 4; ++i) { int cc = tid + 256 * i, row = cc >> 3, kc = cc & 7; rv[i] = *(const u32x4*)(vbase + (size_t)row * S_ + k0 + kc * 8); }
        }
        f32x16 st[2];
        float mnew = 0.f;
        const int key0 = j * 64;
        if (key0 <= qlo + 31) {
          __builtin_amdgcn_s_setprio(1);
#pragma unroll
          for (int kb = 0; kb < 2; ++kb) {
#pragma unroll
            for (int i = 0; i < 16; ++i) st[kb][i] = 0.f;
#pragma unroll
            for (int ks = 0; ks < 4; ++ks) {
              bf16x8 kf = *(const bf16x8*)(sKc + (kb * 32 + r) * LDS_LD + ks * 16 + h * 8);
              st[kb] = mfma32(kf, qf[ks], st[kb]);
            }
          }
          __builtin_amdgcn_s_setprio(0);
          const bool need_mask = (key0 + 63 > qlo);
          float mx = -1e30f;
#pragma unroll
          for (int kb = 0; kb < 2; ++kb)
#pragma unroll
            for (int i = 0; i < 16; ++i) {
              float s = st[kb][i] * LOG2E;
              if (need_mask) { int key = key0 + kb * 32 + crow(i, h); if (key > qlo + r) s = -1e30f; }
              st[kb][i] = s; mx = fmaxf(mx, s);
            }
          mx = fmaxf(mx, xor32(mx));
          mnew = fmaxf(mrow, mx);
          const float alpha = __builtin_amdgcn_exp2f(mrow - mnew);
          mrow = mnew;
          float ps = 0.f;
#pragma unroll
          for (int kb = 0; kb < 2; ++kb)
#pragma unroll
            for (int i = 0; i < 16; ++i) { float p = __builtin_amdgcn_exp2f(st[kb][i] - mnew); st[kb][i] = p; ps += p; }
          lsum = lsum * alpha + ps;
#pragma unroll
          for (int d = 0; d < 4; ++d)
#pragma unroll
            for (int i = 0; i < 16; ++i) o[d][i] *= alpha;
        }
        if (more) {
#pragma unroll
          for (int i = 0; i < 2; ++i) { int cc = tid + 256 * i, row = cc >> 3, kc = cc & 7; *(u32x4*)(sKn + row * LDS_LD + kc * 8) = rk[i]; }
#pragma unroll
          for (int i = 0; i < 4; ++i) { int cc = tid + 256 * i, row = cc >> 3, kc = cc & 7; *(u32x4*)(sVn + row * LDS_LD + kc * 8) = rv[i]; }
        }
        if (key0 <= qlo + 31) {
          __builtin_amdgcn_s_setprio(1);
#pragma unroll
          for (int kb = 0; kb < 2; ++kb)
#pragma unroll
            for (int s = 0; s < 2; ++s) {
              u32x4 pp = {pack2(st[kb][8 * s], st[kb][8 * s + 1]), pack2(st[kb][8 * s + 2], st[kb][8 * s + 3]),
                          pack2(st[kb][8 * s + 4], st[kb][8 * s + 5]), pack2(st[kb][8 * s + 6], st[kb][8 * s + 7])};
              bf16x8 pf = __builtin_bit_cast(bf16x8, pp);
#pragma unroll
              for (int d = 0; d < 4; ++d) {
                const u16* vp = sVc + (d * 32 + r) * LDS_LD + kb * 32 + 16 * s + 4 * h;
                s16x4 lo = *(const s16x4*)vp, hi = *(const s16x4*)(vp + 8);
                bf16x8 vf = __builtin_shufflevector(lo, hi, 0, 1, 2, 3, 4, 5, 6, 7);
                o[d] = mfma32(vf, pf, o[d]);
              }
            }
          __builtin_amdgcn_s_setprio(0);
        }
        __syncthreads();
      }
      const float ltot = lsum + xor32(lsum);
      const float inv = 1.f / ltot;
      if (c == 0) {
#pragma unroll
        for (int d = 0; d < 4; ++d)
#pragma unroll
          for (int q = 0; q < 4; ++q) scr[(d * 4 + q) * 256] = make_float4(o[d][4 * q] * inv, o[d][4 * q + 1] * inv, o[d][4 * q + 2] * inv, o[d][4 * q + 3] * inv);
      } else {
        float ss = 0.f;
        const float li = lam * inv;
#pragma unroll
        for (int d = 0; d < 4; ++d)
#pragma unroll
          for (int q = 0; q < 4; ++q) {
            float4 p0 = scr[(d * 4 + q) * 256];
            float v0 = p0.x - li * o[d][4 * q], v1 = p0.y - li * o[d][4 * q + 1], v2 = p0.z - li * o[d][4 * q + 2], v3 = p0.w - li * o[d][4 * q + 3];
            o[d][4 * q] = v0; o[d][4 * q + 1] = v1; o[d][4 * q + 2] = v2; o[d][4 * q + 3] = v3;
            ss += v0 * v0 + v1 * v1 + v2 * v2 + v3 * v3;
          }
        ss += xor32(ss);
        const float rs = rsqrtf(ss * (1.f / 128.f) + 1e-6f) * 0.8f;
#pragma unroll
        for (int d = 0; d < 4; ++d)
#pragma unroll
          for (int q = 0; q < 4; ++q) {
            const int dv = d * 32 + 8 * q + 4 * h;
            float4 g = *(const float4*)(P.subln_g + dv);
            u32x2 pk = {pack2(o[d][4 * q] * rs * g.x, o[d][4 * q + 1] * rs * g.y), pack2(o[d][4 * q + 2] * rs * g.z, o[d][4 * q + 3] * rs * g.w)};
            *(u32x2*)(CAT + mq * 1024 + hh * 128 + dv) = pk;
          }
      }
    }
  }
}

DI void load8(const u16* p, float (&f)[8]) {
  u32x4 v = *(const u32x4*)p;
  f[0] = bflo(v.x); f[1] = bfhi(v.x); f[2] = bflo(v.y); f[3] = bfhi(v.y); f[4] = bflo(v.z); f[5] = bfhi(v.z); f[6] = bflo(v.w); f[7] = bfhi(v.w);
}
DI void shift8(const u16* zc, bool first, const float* mu, float (&z)[8]) {
  float c[8], p[8];
  load8(zc, c);
  if (first) { for (int e = 0; e < 8; ++e) p[e] = 0.f; } else load8(zc - 1792, p);
  float4 m0 = *(const float4*)mu, m1 = *(const float4*)(mu + 4);
  float mm[8] = {m0.x, m0.y, m0.z, m0.w, m1.x, m1.y, m1.z, m1.w};
#pragma unroll
  for (int e = 0; e < 8; ++e) z[e] = c[e] + (p[e] - c[e]) * mm[e];
}
DI void store8h(u16* dst, const float (&z)[8]) {
  u32x4 o = {pack2(z[0], z[1]), pack2(z[2], z[3]), pack2(z[4], z[5]), pack2(z[6], z[7])};
  *(u32x4*)dst = o;
}
DI void store8f(float* dst, const float (&z)[8]) {
  *(float4*)dst = make_float4(z[0], z[1], z[2], z[3]); *(float4*)(dst + 4) = make_float4(z[4], z[5], z[6], z[7]);
}
DI void phase_rwprep(const Params& P) {
  char* ws = P.ws;
  const u16* ZRW = (const u16*)(ws + OFF_ZRW);
  u16* Rb = (u16*)P.out; u16* Kb = (u16*)P.out + (size_t)T_ * 512;
  u16* Vb = (u16*)(ws + OFF_V); u16* ALb = (u16*)(ws + OFF_AL); u16* L16 = (u16*)(ws + OFF_L16);
  const int lane = threadIdx.x & 63, wave = threadIdx.x >> 6;
  for (int t = blockIdx.x * 4 + wave; t < T_; t += gridDim.x * 4) {
    const bool first = (t & (S_ - 1)) == 0;
    const u16* zc = ZRW + (size_t)t * 1792;
    float z[8];
    shift8(zc + lane * 8, first, P.rw_mu + lane * 8, z);
    store8h(Rb + (size_t)t * 512 + lane * 8, z);
    shift8(zc + 512 + lane * 8, first, P.rw_mu + 512 + lane * 8, z);
    store8h(Kb + (size_t)t * 512 + lane * 8, z);
    {
      float4 k0 = *(const float4*)(P.rw_k_k + lane * 8), k1 = *(const float4*)(P.rw_k_k + lane * 8 + 4);
      float kk[8] = {z[0] * k0.x, z[1] * k0.y, z[2] * k0.z, z[3] * k0.w, z[4] * k1.x, z[5] * k1.y, z[6] * k1.z, z[7] * k1.w};
      float ss = 0.f;
#pragma unroll
      for (int e = 0; e < 8; ++e) ss += kk[e] * kk[e];
      ss = sum8(ss);
      float inv = -1.f / fmaxf(sqrtf(ss), 1e-12f);
#pragma unroll
      for (int e = 0; e < 8; ++e) kk[e] *= inv;
      store8h(ALb + (size_t)t * 512 + lane * 8, kk);
    }
    shift8(zc + 1024 + lane * 8, first, P.rw_mu + 1024 + lane * 8, z);
    store8h(Vb + (size_t)t * 512 + lane * 8, z);
    if (lane < 32) {
      shift8(zc + 1536 + lane * 8, first, P.rw_mu + 1536 + lane * 8, z);
      if (lane < 8) { for (int e = 0; e < 8; ++e) z[e] = tanhf(z[e]); }
      else if (lane >= 16) { for (int e = 0; e < 8; ++e) z[e] = sigmoidf_(z[e]); }
      u32x4 o = {pack2(z[0], z[1]), pack2(z[2], z[3]), pack2(z[4], z[5]), pack2(z[6], z[7])};
      *(u32x4*)(L16 + (size_t)t * 256 + lane * 8) = o;
    }
  }
}

DI void phase_lora(const Params& P, char* smem) {
  u16* sW = (u16*)smem; u16* sX = sW + 128 * LDS_LD;
  char* ws = P.ws;
  const u16* WlT = (const u16*)(ws + OFF_WLT); const u16* L16 = (const u16*)(ws + OFF_L16);
  u16* Kb = (u16*)P.out + (size_t)T_ * 512; const u16* ALb = (const u16*)(ws + OFF_AL);
  u16* BEb = (u16*)(ws + OFF_BE); float* DDb = (float*)(ws + OFF_DD); u16* G16 = (u16*)(ws + OFF_G16);
  const int lane = threadIdx.x & 63, wave = threadIdx.x >> 6, wn = wave >> 1, wm = wave & 1, r = lane & 31, h = lane >> 5;
  constexpr int NT = 12, MT = 256;
  for (int tile = blockIdx.x; tile < NT * MT; tile += gridDim.x) {
    int mt = tile / NT, nt = tile % NT;
    f32x16 acc[2][2]; zero_acc(acc);
    gemm_tile(acc, WlT + (size_t)nt * 128 * 256, 256, L16 + (size_t)mt * 128 * 256, 256, 256, sW, sX);
#pragma unroll
    for (int ai = 0; ai < 2; ++ai)
#pragma unroll
      for (int bi = 0; bi < 2; ++bi) {
        const int nb = nt * 128 + wn * 64 + ai * 32;
        const size_t m = mt * 128 + wm * 64 + bi * 32 + r;
        const f32x16 v = acc[ai][bi];
#pragma unroll
        for (int q = 0; q < 4; ++q) {
          const int ch = (nb & 511) + 8 * q + 4 * h;
          float a4[4] = {v[4 * q], v[4 * q + 1], v[4 * q + 2], v[4 * q + 3]};
          if (nb < 512) {
            float4 w0 = *(const float4*)(P.rw_w0 + ch);
            float ww[4] = {w0.x, w0.y, w0.z, w0.w}, dd[4];
#pragma unroll
            for (int e = 0; e < 4; ++e) {
              float xx = -(ww[e] + a4[e]);
              float sp = fmaxf(xx, 0.f) + log1pf(__expf(-fabsf(xx)));
              float w = -sp - 0.5f;
              dd[e] = __expf(-__expf(w));
            }
            *(float4*)(DDb + m * 512 + ch) = make_float4(dd[0], dd[1], dd[2], dd[3]);
          } else if (nb < 1024) {
            float4 a0 = *(const float4*)(P.rw_a0 + ch), ka = *(const float4*)(P.rw_k_a + ch);
            const u32x2 kvp = *(const u32x2*)(Kb + m * 512 + ch), alp = *(const u32x2*)(ALb + m * 512 + ch);
            const float kv[4] = {bflo(kvp.x), bfhi(kvp.x), bflo(kvp.y), bfhi(kvp.y)}, al[4] = {bflo(alp.x), bfhi(alp.x), bflo(alp.y), bfhi(alp.y)};
            float aa[4] = {sigmoidf_(a0.x + a4[0]), sigmoidf_(a0.y + a4[1]), sigmoidf_(a0.z + a4[2]), sigmoidf_(a0.w + a4[3])};
            u32x2 bo = {pack2(-al[0] * aa[0], -al[1] * aa[1]), pack2(-al[2] * aa[2], -al[3] * aa[3])};
            *(u32x2*)(BEb + m * 512 + ch) = bo;
            u32x2 ko = {pack2(kv[0] * (1.f + (aa[0] - 1.f) * ka.x), kv[1] * (1.f + (aa[1] - 1.f) * ka.y)),
                        pack2(kv[2] * (1.f + (aa[2] - 1.f) * ka.z), kv[3] * (1.f + (aa[3] - 1.f) * ka.w))};
            *(u32x2*)(Kb + m * 512 + ch) = ko;
          } else {
            u32x2 pk = {pack2(a4[0], a4[1]), pack2(a4[2], a4[3])};
            *(u32x2*)(G16 + m * 512 + ch) = pk;
          }
        }
      }
  }
}

constexpr int SC_TB = 8;
constexpr int SC_WLDS = 6 * SC_TB * 64;
template <int MODE>
DI void scan_chunk(const Params& P, int bh, int c, int lane, float* lds) {
  char* ws = P.ws;
  const int b = bh >> 3, h = bh & 7;
  const size_t tok0 = (size_t)b * S_ + (size_t)c * CH_L;
  const size_t base = tok0 * 512 + h * 64;
  const u16* arh[6] = {(const u16*)(ws + OFF_AL) + base, (const u16*)(ws + OFF_BE) + base, nullptr,
                       (const u16*)P.out + (size_t)T_ * 512 + base, (const u16*)P.out + base, (const u16*)(ws + OFF_V) + base};
  const float* ard = (const float*)(ws + OFF_DD) + base;
  float* PM = (float*)(ws + OFF_PM); float* HM = (float*)(ws + OFF_HM);
  f32x2 SA[32], SB[32];
  if (MODE == 0) {
#pragma unroll
    for (int p = 0; p < 32; ++p) { SA[p].x = (2 * p == lane) ? 1.f : 0.f; SA[p].y = (2 * p + 1 == lane) ? 1.f : 0.f; SB[p].x = 0.f; SB[p].y = 0.f; }
  } else if (c == 0) {
#pragma unroll
    for (int p = 0; p < 32; ++p) { SA[p].x = 0.f; SA[p].y = 0.f; }
  } else {
    const float4* src = (const float4*)(HM + ((size_t)(bh * CH_C + c - 1) * 64 + lane) * 64);
#pragma unroll
    for (int q = 0; q < 16; ++q) { float4 v = src[q]; SA[2 * q].x = v.x; SA[2 * q].y = v.y; SA[2 * q + 1].x = v.z; SA[2 * q + 1].y = v.w; }
  }
  float lng = 0.f, lnb = 0.f, rk = 0.f;
  const u16* G16 = (const u16*)(ws + OFF_G16) + base;
  u16* CAT = (u16*)(ws + OFF_ACT) + tok0 * 1024 + 512 + h * 64;
  if (MODE == 2) { lng = P.rw_ln_g[h * 64 + lane]; lnb = P.rw_ln_b[h * 64 + lane]; rk = P.rw_r_k[h * 64 + lane]; }
  const int st_t = lane >> 4, st_q = (lane & 15) * 4;
#pragma unroll 1
  for (int tb = 0; tb < CH_L / SC_TB; ++tb) {
    {
      u32x4 ph[6]; f32x4 pd[2];
#pragma unroll
      for (int a = 0; a < 6; ++a) {
        if (a == 2 || (MODE == 0 && a == 4)) continue;
        ph[a] = *(const u32x4*)(arh[a] + (size_t)(tb * SC_TB + (lane >> 3)) * 512 + (lane & 7) * 8);
      }
#pragma unroll
      for (int f = 0; f < 2; ++f) pd[f] = *(const f32x4*)(ard + (size_t)(tb * SC_TB + f * 4 + st_t) * 512 + st_q);
#pragma unroll
      for (int a = 0; a < 6; ++a) {
        if (a == 2 || (MODE == 0 && a == 4)) continue;
        float* dst = lds + (a * SC_TB + (lane >> 3)) * 64 + (lane & 7) * 8;
        f32x4 lo = {bflo(ph[a].x), bfhi(ph[a].x), bflo(ph[a].y), bfhi(ph[a].y)}, hi = {bflo(ph[a].z), bfhi(ph[a].z), bflo(ph[a].w), bfhi(ph[a].w)};
        *(f32x4*)dst = lo; *(f32x4*)(dst + 4) = hi;
      }
#pragma unroll
      for (int f = 0; f < 2; ++f) *(f32x4*)(lds + ((4 + f) * 64 + lane) * 4) = pd[f];
    }
#pragma unroll 1
    for (int t = 0; t < SC_TB; ++t) {
      const float* la = lds + t * 64;
      const float vi = la[5 * SC_TB * 64 + lane];
      float gbits = 0.f;
      if (MODE == 2) gbits = __uint_as_float((u32)G16[(size_t)(tb * SC_TB + t) * 512 + lane] << 16);
      f32x2 sa2 = {0.f, 0.f}, sb2 = {0.f, 0.f};
#pragma unroll
      for (int q = 0; q < 16; ++q) {
        if ((q & 3) == 0) asm volatile("" ::: "memory");
        const f32x4 al = *(const f32x4*)(la + 4 * q);
        const f32x2 al0 = {al.x, al.y}, al1 = {al.z, al.w};
        sa2 = SA[2 * q] * al0 + sa2; sa2 = SA[2 * q + 1] * al1 + sa2;
        if (MODE == 0) { sb2 = SB[2 * q] * al0 + sb2; sb2 = SB[2 * q + 1] * al1 + sb2; }
      }
      const float sa = sa2.x + sa2.y, sb = sb2.x + sb2.y;
      const f32x2 sav = {sa, sa}, sbv = {sb, sb}, viv = {vi, vi};
      f32x2 y2 = {0.f, 0.f};
#pragma unroll
      for (int q = 0; q < 16; ++q) {
        if ((q & 1) == 0) asm volatile("" ::: "memory");
        const f32x4 be = *(const f32x4*)(la + 1 * SC_TB * 64 + 4 * q);
        const f32x4 dd = *(const f32x4*)(la + 2 * SC_TB * 64 + 4 * q);
        const f32x4 kk = *(const f32x4*)(la + 3 * SC_TB * 64 + 4 * q);
        const f32x2 be0 = {be.x, be.y}, be1 = {be.z, be.w}, dd0 = {dd.x, dd.y}, dd1 = {dd.z, dd.w}, kk0 = {kk.x, kk.y}, kk1 = {kk.z, kk.w};
        if (MODE == 0) {
          SA[2 * q] = SA[2 * q] * dd0 + sav * be0; SA[2 * q + 1] = SA[2 * q + 1] * dd1 + sav * be1;
          SB[2 * q] = SB[2 * q] * dd0 + (viv * kk0 + sbv * be0); SB[2 * q + 1] = SB[2 * q + 1] * dd1 + (viv * kk1 + sbv * be1);
        } else {
          const f32x4 rr = *(const f32x4*)(la + 4 * SC_TB * 64 + 4 * q);
          const f32x2 rr0 = {rr.x, rr.y}, rr1 = {rr.z, rr.w};
          SA[2 * q] = SA[2 * q] * dd0 + (viv * kk0 + sav * be0); SA[2 * q + 1] = SA[2 * q + 1] * dd1 + (viv * kk1 + sav * be1);
          y2 = SA[2 * q] * rr0 + y2; y2 = SA[2 * q + 1] * rr1 + y2;
        }
      }
      if (MODE == 2) {
        const float y = y2.x + y2.y;
        const float rj = la[4 * SC_TB * 64 + lane], kj = la[3 * SC_TB * 64 + lane];
        const float mean = wave_sum(y) * (1.f / 64.f);
        const float dv = y - mean;
        const float var = wave_sum(dv * dv) * (1.f / 64.f);
        const float bonus = wave_sum(rj * kj * rk);
        float yn = dv * rsqrtf(var + 64e-5f) * lng + lnb;
        yn += bonus * vi;
        CAT[(size_t)(tb * SC_TB + t) * 1024 + lane] = f2bf(yn * gbits);
      }
    }
  }
  if (MODE == 0) {
    float4* dp = (float4*)(PM + ((size_t)(bh * CH_C + c) * 64 + lane) * 64);
    float4* dh = (float4*)(HM + ((size_t)(bh * CH_C + c) * 64 + lane) * 64);
#pragma unroll
    for (int q = 0; q < 16; ++q) {
      dp[q] = make_float4(SA[2 * q].x, SA[2 * q].y, SA[2 * q + 1].x, SA[2 * q + 1].y);
      dh[q] = make_float4(SB[2 * q].x, SB[2 * q].y, SB[2 * q + 1].x, SB[2 * q + 1].y);
    }
  }
}
DI void phase_scan1(const Params& P, char* smem) {
  const int lane = threadIdx.x & 63;
  const int wave = __builtin_amdgcn_readfirstlane((int)(threadIdx.x >> 6));
  float* lds = (float*)smem + wave * SC_WLDS;
  const int nitems = 32 * (CH_C - 1);
  for (int it = blockIdx.x * 4 + wave; it < nitems; it += gridDim.x * 4) scan_chunk<0>(P, it / (CH_C - 1), it % (CH_C - 1), lane, lds);
}
DI void phase_scan2(const Params& P, char* smem) {
  constexpr int SLD = 68;
  float* sA = (float*)smem;
  char* ws = P.ws;
  float* HM = (float*)(ws + OFF_HM); const float* PM = (const float*)(ws + OFF_PM);
  const int lane = threadIdx.x & 63, wave = threadIdx.x >> 6, ib = wave >> 1, jb = wave & 1, r = lane & 31, g = lane >> 5;
  for (int bh = blockIdx.x; bh < 32; bh += gridDim.x) {
    float av[32];
    {
      const float* s0 = HM + ((size_t)(bh * CH_C) * 64 + 32 * ib + r) * 64 + g;
#pragma unroll
      for (int kk = 0; kk < 32; ++kk) av[kk] = s0[2 * kk];
    }
#pragma unroll 1
    for (int c = 1; c <= CH_C - 2; ++c) {
      const float* pb = PM + ((size_t)(bh * CH_C + c) * 64 + g) * 64 + 32 * jb + r;
      float* hb = HM + ((size_t)(bh * CH_C + c) * 64 + 32 * ib + 4 * g) * 64 + 32 * jb + r;
      f32x16 acc;
#pragma unroll
      for (int q = 0; q < 16; ++q) acc[q] = hb[(size_t)((q & 3) + 8 * (q >> 2)) * 64];
      float bv[32];
#pragma unroll
      for (int kk = 0; kk < 32; ++kk) bv[kk] = pb[(size_t)(2 * kk) * 64];
#pragma unroll
      for (int kk = 0; kk < 32; ++kk) acc = __builtin_amdgcn_mfma_f32_32x32x2f32(av[kk], bv[kk], acc, 0, 0, 0);
      const int j = 32 * jb + r;
      __syncthreads();
#pragma unroll
      for (int q = 0; q < 16; ++q) {
        const int il = (q & 3) + 8 * (q >> 2) + 4 * g;
        hb[(size_t)((q & 3) + 8 * (q >> 2)) * 64] = acc[q];
        sA[(32 * ib + il) * SLD + (j & 1) * 32 + (j >> 1)] = acc[q];
      }
      __syncthreads();
#pragma unroll
      for (int k4 = 0; k4 < 8; ++k4) {
        const float4 v = *(const float4*)(sA + (32 * ib + r) * SLD + g * 32 + 4 * k4);
        av[4 * k4] = v.x; av[4 * k4 + 1] = v.y; av[4 * k4 + 2] = v.z; av[4 * k4 + 3] = v.w;
      }
    }
  }
}
DI void phase_scan3(const Params& P, char* smem) {
  const int lane = threadIdx.x & 63;
  const int wave = __builtin_amdgcn_readfirstlane((int)(threadIdx.x >> 6));
  float* lds = (float*)smem + wave * SC_WLDS;
  const int nitems = 32 * CH_C;
  for (int it = blockIdx.x * 4 + wave; it < nitems; it += gridDim.x * 4) scan_chunk<2>(P, it / CH_C, it % CH_C, lane, lds);
}

DI void phase_outproj(const Params& P, char* smem) {
  u16* sW = (u16*)smem; u16* sX = sW + 128 * LDS_LD;
  char* ws = P.ws;
  const u16* Wt = (const u16*)(ws + OFF_WOUTT); const u16* CAT = (const u16*)(ws + OFF_ACT);
  const int lane = threadIdx.x & 63, wave = threadIdx.x >> 6, wn = wave >> 1, wm = wave & 1, r = lane & 31, h = lane >> 5;
  constexpr int NT = 8, MT = 256;
  for (int tile = blockIdx.x; tile < NT * MT; tile += gridDim.x) {
    int mt = tile / NT, nt = tile % NT;
    f32x16 acc[2][2]; zero_acc(acc);
    gemm_tile(acc, Wt + (size_t)nt * 128 * 1024, 1024, CAT + (size_t)mt * 128 * 1024, 1024, 1024, sW, sX);
#pragma unroll
    for (int ai = 0; ai < 2; ++ai)
#pragma unroll
      for (int bi = 0; bi < 2; ++bi) {
        const int nb = nt * 128 + wn * 64 + ai * 32;
        const size_t m = mt * 128 + wm * 64 + bi * 32 + r;
#pragma unroll
        for (int q = 0; q < 4; ++q) {
          const int n = nb + 8 * q + 4 * h;
          float4 xv = *(const float4*)(P.x + m * 1024 + n);
          *(float4*)(P.out + m * 1024 + n) = make_float4(xv.x + acc[ai][bi][4 * q], xv.y + acc[ai][bi][4 * q + 1], xv.z + acc[ai][bi][4 * q + 2], xv.w + acc[ai][bi][4 * q + 3]);
        }
      }
  }
}

DI void phase_qproj(const Params& P, char* smem, int half) {
  u16* sW = (u16*)smem; u16* sX = sW + 128 * LDS_LD;
  char* ws = P.ws;
  const u16* Wt = (const u16*)(ws + OFF_WQT); const u16* A = (const u16*)(ws + OFF_ACT); u16* Q16 = (u16*)(ws + OFF_Q16);
  const int lane = threadIdx.x & 63, wave = threadIdx.x >> 6, wn = wave >> 1, wm = wave & 1, r = lane & 31, h = lane >> 5;
  constexpr int NT = 16, MT = 128;
  for (int tile = blockIdx.x; tile < NT * MT; tile += gridDim.x) {
    int mt = tile / NT, nt = tile % NT;
    f32x16 acc[2][2]; zero_acc(acc);
    gemm_tile(acc, Wt + (size_t)nt * 128 * 1024, 1024, A + (size_t)(half * 128 + mt) * 128 * 1024, 1024, 1024, sW, sX);
#pragma unroll
    for (int ai = 0; ai < 2; ++ai)
#pragma unroll
      for (int bi = 0; bi < 2; ++bi) {
        const int nb = nt * 128 + wn * 64 + ai * 32;
        const size_t m = mt * 128 + wm * 64 + bi * 32 + r;
#pragma unroll
        for (int q = 0; q < 4; ++q) {
          u32x2 pk = {pack2(acc[ai][bi][4 * q], acc[ai][bi][4 * q + 1]), pack2(acc[ai][bi][4 * q + 2], acc[ai][bi][4 * q + 3])};
          *(u32x2*)(Q16 + m * 2048 + nb + 8 * q + 4 * h) = pk;
        }
      }
  }
}
DI void phase_scores(const Params& P, char* smem) {
  u16* sW = (u16*)smem; u16* sX = sW + 128 * LDS_LD;
  char* ws = P.ws;
  const u16* SK = (const u16*)(ws + OFF_SUBK); const u16* Q16 = (const u16*)(ws + OFF_Q16); float* ST = (float*)(ws + OFF_ST);
  const int lane = threadIdx.x & 63, wave = threadIdx.x >> 6, wn = wave >> 1, wm = wave & 1, r = lane & 31, h = lane >> 5;
  for (int tile = blockIdx.x; tile < 16 * 128; tile += gridDim.x) {
    int mt = tile >> 4, hp = tile & 15;
    f32x16 acc[2][2]; zero_acc(acc);
    gemm_tile(acc, SK + (size_t)hp * 128 * 128, 128, Q16 + (size_t)mt * 128 * 2048 + hp * 128, 2048, 128, sW, sX);
#pragma unroll
    for (int ai = 0; ai < 2; ++ai)
#pragma unroll
      for (int bi = 0; bi < 2; ++bi) {
        const int nb = wn * 64 + ai * 32;
        const size_t m = mt * 128 + wm * 64 + bi * 32 + r;
#pragma unroll
        for (int i = 0; i < 16; ++i) ST[((size_t)(hp * 128 + nb + crow(i, h))) * TH_ + m] = acc[ai][bi][i];
      }
  }
}
DI u32 ford(float f) { u32 u = __float_as_uint(f); return u ^ ((u32)((int)u >> 31) | 0x80000000u); }
DI float funord(u32 k) { u32 u = (k & 0x80000000u) ? (k ^ 0x80000000u) : ~k; return __uint_as_float(u); }
DI void ins16(u32 (&L)[16], u32 x) {
#pragma unroll
  for (int k = 0; k < 16; ++k) { u32 hi = max(L[k], x); x = min(L[k], x); L[k] = hi; }
}
DI void phase_topk(const Params& P, int half) {
  char* ws = P.ws;
  const float* ST = (const float*)(ws + OFF_ST); int* IDX = (int*)(ws + OFF_IDX); float* GATE = (float*)(ws + OFF_GATE);
  const int lane = threadIdx.x & 63, wave = threadIdx.x >> 6;
  for (int it = blockIdx.x * 4 + wave; it < (TH_ / 64) * 8; it += gridDim.x * 4) {
    const int hd = it & 7, tl = (it >> 3) * 64 + lane, t = half * TH_ + tl;
    u32 L1[16], L2[16];
#pragma unroll
    for (int k = 0; k < 16; ++k) { L1[k] = 0u; L2[k] = 0u; }
    const float* s1 = ST + ((size_t)(hd * 2) * 128) * TH_ + tl;
    const float* s2 = ST + ((size_t)(hd * 2 + 1) * 128) * TH_ + tl;
#pragma unroll 8
    for (int n = 0; n < 128; ++n) {
      ins16(L1, (ford(s1[(size_t)n * TH_]) & ~127u) | (u32)(127 - n));
      ins16(L2, (ford(s2[(size_t)n * TH_]) & ~127u) | (u32)(127 - n));
    }
    float v1[16], v2[16];
#pragma unroll
    for (int k = 0; k < 16; ++k) { v1[k] = funord(L1[k] & ~127u); v2[k] = funord(L2[k] & ~127u); }
    u32 C[16];
#pragma unroll
    for (int k = 0; k < 16; ++k) C[k] = 0u;
#pragma unroll
    for (int a = 0; a < 16; ++a)
#pragma unroll
      for (int bb = 0; bb < 16; ++bb)
        if ((a + 1) * (bb + 1) <= 16) ins16(C, (ford(v1[a] + v2[bb]) & ~255u) | (u32)(255 - (a * 16 + bb)));
    float best[16]; float den = 0.f;
    const float m0 = funord(C[0] & ~255u);
#pragma unroll
    for (int k = 0; k < 16; ++k) { best[k] = __expf(funord(C[k] & ~255u) - m0); den += best[k]; }
    const float rden = 1.f / den;
#pragma unroll
    for (int k4 = 0; k4 < 4; ++k4) {
      int id[4];
#pragma unroll
      for (int u = 0; u < 4; ++u) {
        const int k = k4 * 4 + u;
        const int ab = 255 - (int)(C[k] & 255u), a = ab >> 4, bb = ab & 15;
        u32 e1 = 0, e2 = 0;
#pragma unroll
        for (int q = 0; q < 16; ++q) { e1 = (a == q) ? L1[q] : e1; e2 = (bb == q) ? L2[q] : e2; }
        id[u] = (127 - (int)(e1 & 127u)) * 128 + (127 - (int)(e2 & 127u));
      }
      *(int4*)(IDX + (size_t)t * 128 + hd * 16 + k4 * 4) = make_int4(id[0], id[1], id[2], id[3]);
      *(float4*)(GATE + (size_t)t * 128 + hd * 16 + k4 * 4) = make_float4(best[k4 * 4] * rden, best[k4 * 4 + 1] * rden, best[k4 * 4 + 2] * rden, best[k4 * 4 + 3] * rden);
    }
  }
}
DI float gelu_(float x) { return 0.5f * x * (1.f + erff(x * 0.70710678118654752f)); }
DI void fp8x16_to_f32(u32x4 v, float (&f)[16]) {
  const u32 w[4] = {v.x, v.y, v.z, v.w};
#pragma unroll
  for (int k = 0; k < 4; ++k) {
    f32x2 lo = __builtin_amdgcn_cvt_pk_f32_fp8((int)w[k], false), hi = __builtin_amdgcn_cvt_pk_f32_fp8((int)w[k], true);
    f[4 * k] = lo.x; f[4 * k + 1] = lo.y; f[4 * k + 2] = hi.x; f[4 * k + 3] = hi.y;
  }
}
DI void phase_gather(const Params& P) {
  char* ws = P.ws;
  const int* IDX = (const int*)(ws + OFF_IDX); const float* GATE = (const float*)(ws + OFF_GATE);
  const unsigned char* PU = (const unsigned char*)(ws + OFF_PU16); const unsigned char* PV = (const unsigned char*)(ws + OFF_PV16);
  u16* ACT = (u16*)(ws + OFF_ACT);
  const int lane = threadIdx.x & 63, wave = threadIdx.x >> 6;
  for (int t = blockIdx.x * 4 + wave; t < T_; t += gridDim.x * 4) {
    const u16* xr = ACT + (size_t)t * 1024 + lane * 16;
    float xf[16];
    {
      const u32x4 x0 = *(const u32x4*)xr, x1 = *(const u32x4*)(xr + 8);
      xf[0] = bflo(x0.x); xf[1] = bfhi(x0.x); xf[2] = bflo(x0.y); xf[3] = bfhi(x0.y); xf[4] = bflo(x0.z); xf[5] = bfhi(x0.z); xf[6] = bflo(x0.w); xf[7] = bfhi(x0.w);
      xf[8] = bflo(x1.x); xf[9] = bfhi(x1.x); xf[10] = bflo(x1.y); xf[11] = bfhi(x1.y); xf[12] = bflo(x1.z); xf[13] = bfhi(x1.z); xf[14] = bflo(x1.w); xf[15] = bfhi(x1.w);
    }
    int id[2]; float gt[2];
    id[0] = IDX[(size_t)t * 128 + lane]; id[1] = IDX[(size_t)t * 128 + 64 + lane];
    gt[0] = GATE[(size_t)t * 128 + lane]; gt[1] = GATE[(size_t)t * 128 + 64 + lane];
    float acc[16];
#pragma unroll
    for (int k = 0; k < 16; ++k) acc[k] = 0.f;
#pragma unroll
    for (int hf = 0; hf < 2; ++hf) {
#pragma unroll 1
      for (int hq = 0; hq < 4; ++hq) {
        u32x4 rec[16];
#pragma unroll
        for (int j = 0; j < 16; ++j) {
          const int row = __builtin_amdgcn_readlane(id[hf], hq * 16 + j);
          rec[j] = *(const u32x4*)(PU + (size_t)row * 1024 + lane * 16);
        }
        float dsel = 0.f;
        const int li = lane & 15;
#pragma unroll
        for (int j = 0; j < 16; ++j) {
          float uf[16]; fp4x8_to_f32(rec[j].x, uf); fp4x8_to_f32(rec[j].y, uf + 8);
          float p0 = 0.f, p1 = 0.f;
#pragma unroll
          for (int k = 0; k < 16; k += 2) { p0 = fmaf(uf[k], xf[k], p0); p1 = fmaf(uf[k + 1], xf[k + 1], p1); }
          float rs = sum8(p0 + p1); rs += dppf<0x140>(rs);
          dsel = (li == j) ? rs : dsel;
        }
        dsel += __shfl_xor(dsel, 16);
        dsel += __shfl_xor(dsel, 32);
        const float wsel = 0.1f * gt[hf] * gelu_(dsel * 0.015625f);
#pragma unroll
        for (int j = 0; j < 16; ++j) {
          const float w = rlf(wsel, hq * 16 + j);
          float vf[16]; fp4x8_to_f32(rec[j].z, vf); fp4x8_to_f32(rec[j].w, vf + 8);
#pragma unroll
          for (int k = 0; k < 16; ++k) acc[k] = fmaf(w, vf[k], acc[k]);
        }
      }
    }
    float* hr = P.out + (size_t)t * 1024 + lane * 16;
    float ss = 0.f;
#pragma unroll
    for (int q = 0; q < 4; ++q) {
      float4 hv = *(const float4*)(hr + 4 * q);
      hv.x += acc[4 * q]; hv.y += acc[4 * q + 1]; hv.z += acc[4 * q + 2]; hv.w += acc[4 * q + 3];
      *(float4*)(hr + 4 * q) = hv;
      acc[4 * q] = hv.x; acc[4 * q + 1] = hv.y; acc[4 * q + 2] = hv.z; acc[4 * q + 3] = hv.w;
      ss += hv.x * hv.x + hv.y * hv.y + hv.z * hv.z + hv.w * hv.w;
    }
    ss = wave_sum(ss);
    const float rs = rsqrtf(ss * (1.f / 1024.f) + 1e-6f);
    const float* g = P.norm_ple_g + lane * 16;
    u32 o[8];
#pragma unroll
    for (int q = 0; q < 4; ++q) {
      float4 gg = *(const float4*)(g + 4 * q);
      o[2 * q] = pack2(acc[4 * q] * rs * gg.x, acc[4 * q + 1] * rs * gg.y); o[2 * q + 1] = pack2(acc[4 * q + 2] * rs * gg.z, acc[4 * q + 3] * rs * gg.w);
    }
    u32x4 o0 = {o[0], o[1], o[2], o[3]}, o1 = {o[4], o[5], o[6], o[7]};
    *(u32x4*)(ACT + (size_t)t * 1024 + lane * 16) = o0; *(u32x4*)(ACT + (size_t)t * 1024 + lane * 16 + 8) = o1;
  }
}
DI void phase_ple(const Params& P, char* smem) {
  u16* sW = (u16*)smem; u16* sX = sW + 128 * LDS_LD;
  char* ws = P.ws;
  const u16* WgT = (const u16*)(ws + OFF_WGT); const u16* WpT = (const u16*)(ws + OFF_WPT);
  const u16* A = (const u16*)(ws + OFF_ACT); const u16* P16 = (const u16*)(ws + OFF_P16);
  const int lane = threadIdx.x & 63, wave = threadIdx.x >> 6, wn = wave >> 1, wm = wave & 1, r = lane & 31, h = lane >> 5;
  constexpr int NT = 8, MT = 256;
  for (int tile = blockIdx.x; tile < NT * MT; tile += gridDim.x) {
    int mt = tile / NT, nt = tile % NT;
    f32x16 acc[2][2], acc2[2][2]; zero_acc(acc); zero_acc(acc2);
    gemm_tile(acc, WgT + (size_t)nt * 128 * 1024, 1024, A + (size_t)mt * 128 * 1024, 1024, 1024, sW, sX);
    gemm_tile(acc2, WpT + (size_t)nt * 128 * 256, 256, P16 + (size_t)mt * 128 * 256, 256, 256, sW, sX);
#pragma unroll
    for (int ai = 0; ai < 2; ++ai)
#pragma unroll
      for (int bi = 0; bi < 2; ++bi) {
        const int nb = nt * 128 + wn * 64 + ai * 32;
        const size_t m = mt * 128 + wm * 64 + bi * 32 + r;
#pragma unroll
        for (int q = 0; q < 4; ++q) {
          const int n = nb + 8 * q + 4 * h;
          float4 hv = *(const float4*)(P.out + m * 1024 + n);
          hv.x += sigmoidf_(acc[ai][bi][4 * q]) * acc2[ai][bi][4 * q];
          hv.y += sigmoidf_(acc[ai][bi][4 * q + 1]) * acc2[ai][bi][4 * q + 1];
          hv.z += sigmoidf_(acc[ai][bi][4 * q + 2]) * acc2[ai][bi][4 * q + 2];
          hv.w += sigmoidf_(acc[ai][bi][4 * q + 3]) * acc2[ai][bi][4 * q + 3];
          *(float4*)(P.out + m * 1024 + n) = hv;
        }
      }
  }
}
DI void phase_final(const Params& P) {
  const int lane = threadIdx.x & 63, wave = threadIdx.x >> 6;
  for (int t = blockIdx.x * 4 + wave; t < T_; t += gridDim.x * 4) {
    float4* row = (float4*)(P.out + (size_t)t * 1024);
    float4 v[4]; float ss = 0.f;
#pragma unroll
    for (int i = 0; i < 4; ++i) { v[i] = row[lane + 64 * i]; ss += v[i].x * v[i].x + v[i].y * v[i].y + v[i].z * v[i].z + v[i].w * v[i].w; }
    ss = wave_sum(ss);
    const float rs = rsqrtf(ss * (1.f / 1024.f) + 1e-6f);
#pragma unroll
    for (int i = 0; i < 4; ++i) {
      float4 g = ((const float4*)P.norm_final_g)[lane + 64 * i];
      row[lane + 64 * i] = make_float4(v[i].x * rs * g.x, v[i].y * rs * g.y, v[i].z * rs * g.z, v[i].w * rs * g.w);
    }
  }
}

#ifndef PH_MASK
#define PH_MASK 0xFFFFFFFFu
#endif
#define PH(n) if ((PH_MASK >> (n)) & 1u)
#define XB_TMO      128
#define XB_XCNT(j)  (256  + 64 * (j))
#define XB_XSUB(j)  (1280 + 64 * (j))
#define XB_XGEN(j)  (2304 + 64 * (j))
#define XB_TOP      3328
#define XB_TOPGEN   3392
#define XCD_BAR_WORDS 3456
#define XB_SPIN_CAP (1u << 18)
#define LAS __attribute__((address_space(3)))

__device__ __forceinline__ unsigned xb_ld(unsigned* p)              { return __hip_atomic_load(p, __ATOMIC_RELAXED, __HIP_MEMORY_SCOPE_AGENT); }
__device__ __forceinline__ unsigned xb_add(unsigned* p, unsigned v) { return __hip_atomic_fetch_add(p, v, __ATOMIC_RELAXED, __HIP_MEMORY_SCOPE_AGENT); }
__device__ __forceinline__ unsigned xb_xcc_id() { return (unsigned)__builtin_amdgcn_s_getreg((3 << 11) | 20) & 0xFu; }
#define XB_SPIN(cond, bar) do { unsigned _sp = 0; while (cond) { __builtin_amdgcn_s_sleep(1); \
    if ((++_sp & 255u) == 0u) { if (xb_ld(&(bar)[XB_TMO])) break; if (_sp > XB_SPIN_CAP) { atomicAdd(&(bar)[XB_TMO], 1u); break; } } } } while (0)

struct XcdBarrier {
    unsigned* bar; unsigned x;
    volatile LAS unsigned* st;
};

__device__ __forceinline__ XcdBarrier xcd_barrier_post(unsigned* bar, volatile LAS unsigned* st) {
    XcdBarrier b; b.bar = bar; b.x = xb_xcc_id(); b.st = st;
    if (threadIdx.x == 0) (void)xb_add(&bar[XB_XCNT(b.x)], 1u);
    return b;
}
__device__ __forceinline__ void xcd_barrier_complete(unsigned* bar, unsigned x, unsigned& nloc, unsigned& nx) {
    const unsigned G = gridDim.x * gridDim.y * gridDim.z;
    unsigned sum, cnt, mine, sp = 0u;
    for (;;) {
        sum = 0u; cnt = 0u; mine = 0u;
#pragma unroll
        for (unsigned j = 0; j < 16; ++j) { const unsigned c = xb_ld(&bar[XB_XCNT(j)]); sum += c; cnt += (c > 0u) ? 1u : 0u; mine = (j == x) ? c : mine; }
        if (sum == G) break;
        __builtin_amdgcn_s_sleep(1);
        if ((++sp & 255u) == 0u) { if (xb_ld(&bar[XB_TMO])) break; if (sp > XB_SPIN_CAP) { atomicAdd(&bar[XB_TMO], 1u); break; } }
    }
    nloc = mine > 0u ? mine : 1u; nx = cnt > 0u ? cnt : 1u;
}

__device__ __forceinline__ void xcd_barrier(const XcdBarrier& b) {
    asm volatile("s_waitcnt vmcnt(0)" ::: "memory");
    __syncthreads();
    if (threadIdx.x == 0) {
        unsigned* bar = b.bar;
        __builtin_amdgcn_s_waitcnt(0);
        unsigned nloc = b.st[0], nx = b.st[1];
        if (nloc == 0u) { xcd_barrier_complete(bar, b.x, nloc, nx); b.st[0] = nloc; b.st[1] = nx; }
        const unsigned old = xb_add(&bar[XB_XSUB(b.x)], 1u);
        const unsigned gen = old / nloc;
        if (old + 1u == (gen + 1u) * nloc) {
            __builtin_amdgcn_fence(__ATOMIC_RELEASE, "agent");
            asm volatile("s_waitcnt vmcnt(0)" ::: "memory");
            const unsigned og = xb_add(&bar[XB_TOP], 1u);
            const unsigned tg = og / nx;
            if (og + 1u == (tg + 1u) * nx) xb_add(&bar[XB_TOPGEN], 1u);
            else XB_SPIN(xb_ld(&bar[XB_TOPGEN]) == tg, bar);
            __builtin_amdgcn_fence(__ATOMIC_ACQUIRE, "agent");
            xb_add(&bar[XB_XGEN(b.x)], 1u);
            asm volatile("s_waitcnt vmcnt(0)" ::: "memory");
        } else {
            XB_SPIN(xb_ld(&bar[XB_XGEN(b.x)]) == gen, bar);
            __builtin_amdgcn_fence(__ATOMIC_ACQUIRE, "agent");
            asm volatile("s_waitcnt vmcnt(0)" ::: "memory");
        }
    }
    __syncthreads();
}

constexpr int SMEM_BYTES = 2 * 2 * 128 * LDS_LD * 2;

__global__ void __launch_bounds__(256, 2) mega(Params P) {
  __shared__ __attribute__((aligned(16))) char smem[SMEM_BYTES];
  cg::grid_group grid = cg::this_grid();
  __shared__ __attribute__((aligned(16))) unsigned xb_st[4];
  if (threadIdx.x < 4) xb_st[threadIdx.x] = 0u;
  __syncthreads();
  XcdBarrier xb = xcd_barrier_post((unsigned*)(P.ws + OFF_CTR + 4096), (volatile LAS unsigned*)xb_st);
#define RUN(n, ...) PH(n) { if (P.ph_lo <= (n) && (n) <= P.ph_hi) { __VA_ARGS__; } } if (P.ph_lo <= (n) && (n) < P.ph_hi) { if ((n) == 0) grid.sync(); else xcd_barrier(xb); }
  RUN(0, phase_prep(P, smem))
  RUN(1, phase_gemm1(P, smem))
  RUN(2, phase_attn(P, smem); phase_rwprep(P))
  RUN(4, phase_lora(P, smem))
  RUN(5, phase_scan1(P, smem))
  RUN(6, phase_scan2(P, smem))
  RUN(7, phase_scan3(P, smem))
  RUN(8, phase_outproj(P, smem); convert_flat(P.p, (u16*)(P.ws + OFF_P16), (size_t)T_ * 256);
         convert_uv_fp4(P.peer_u, P.peer_v, (unsigned char*)(P.ws + OFF_PU16), 64.f, 10.f))
  RUN(9, rmsnorm_rows(P.out, P.norm_ffn_g, (u16*)(P.ws + OFF_ACT)))
  RUN(10, phase_qproj(P, smem, 0))
  RUN(11, phase_scores(P, smem))
  RUN(12, phase_qproj(P, smem, 1); phase_topk(P, 0))
  RUN(14, phase_scores(P, smem))
  RUN(15, phase_topk(P, 1))
  RUN(16, phase_gather(P))
  RUN(17, phase_ple(P, smem))
  RUN(18, phase_final(P))
}

extern "C" void kernel_launch(void* const* d_in, const int* in_sizes, int n_in, void* d_out, int out_size, void* d_ws, size_t ws_size,
                              hipStream_t stream) {
  static int grid_blocks = 0;
  if (!grid_blocks) {
    int dev = 0, cus = 0, per_cu = 0;
    hipGetDevice(&dev);
    hipDeviceGetAttribute(&cus, hipDeviceAttributeMultiprocessorCount, dev);
    hipOccupancyMaxActiveBlocksPerMultiprocessor(&per_cu, mega, 256, 0);
    if (per_cu < 1) per_cu = 1;
    if (per_cu > 2) per_cu = 2;
    grid_blocks = cus * per_cu;
  }
  Params P{};
  const float* const* fi = (const float* const*)d_in;
  P.x = fi[0]; P.p = fi[1]; P.pos = (const int*)d_in[2];
  P.norm_mix_g = fi[3]; P.w_in = fi[4]; P.lam_q1 = fi[5]; P.lam_k1 = fi[6]; P.lam_q2 = fi[7]; P.lam_k2 = fi[8]; P.subln_g = fi[9];
  P.rw_mu = fi[10]; P.rw_w0 = fi[11]; P.rw_w_up = fi[12]; P.rw_a0 = fi[13]; P.rw_a_up = fi[14]; P.rw_g_up = fi[15];
  P.rw_k_k = fi[16]; P.rw_k_a = fi[17]; P.rw_r_k = fi[18]; P.rw_ln_g = fi[19]; P.rw_ln_b = fi[20];
  P.w_out = fi[21]; P.norm_ffn_g = fi[22]; P.peer_w_q = fi[23]; P.peer_sub_keys = fi[24]; P.peer_u = fi[25]; P.peer_v = fi[26];
  P.norm_ple_g = fi[27]; P.ple_gate_w = fi[28]; P.ple_proj_w = fi[29]; P.norm_final_g = fi[30];
  P.out = (float*)d_out; P.ws = (char*)d_ws;
  for (int i = 0; i < 8; ++i) P.inv_freq[i] = (float)pow(500000.0, -(double)i / 8.0);
  hipMemsetAsync((char*)d_ws + OFF_CTR, 0, 32768, stream);
#ifndef ONE_LAUNCH
  for (int ph = 0; ph < 19; ++ph) {
    P.ph_lo = ph; P.ph_hi = ph;
    hipLaunchKernelGGL(mega, dim3(grid_blocks), dim3(256), 0, stream, P);
  }
#else
  P.ph_lo = 0; P.ph_hi = 18;
  void* args[] = {&P};
  hipLaunchCooperativeKernel((void*)mega, dim3(grid_blocks), dim3(256), args, 0, stream);
#endif
}
```

```cpp
#include <hip/hip_runtime.h>
#include <hip/hip_cooperative_groups.h>
#include <stdint.h>
#include <math.h>
namespace cg = cooperative_groups;

#define DI __device__ __forceinline__
#define ONE_LAUNCH 1
typedef unsigned short u16;
typedef unsigned int u32;
typedef __attribute__((ext_vector_type(4))) unsigned u32x4;
typedef __attribute__((ext_vector_type(2))) unsigned u32x2;
typedef __attribute__((ext_vector_type(8))) short bf16x8;
typedef __attribute__((ext_vector_type(4))) short s16x4;
typedef __attribute__((ext_vector_type(16))) float f32x16;
typedef __attribute__((ext_vector_type(2))) float f32x2;
typedef __attribute__((ext_vector_type(4))) float f32x4;
typedef __attribute__((ext_vector_type(2))) __bf16 bf16x2;
typedef const float __attribute__((address_space(4)))* cfptr;

constexpr int T_ = 32768, S_ = 8192, TH_ = 16384;
constexpr int CH_L = 128;
constexpr int CH_C = S_ / CH_L;
constexpr int NPHASE = 17;

constexpr size_t MiB = 1u << 20;
constexpr size_t OFF_WINT = 0;
constexpr size_t OFF_WOUTT = 7 * MiB;
constexpr size_t OFF_WQT = 9 * MiB;
constexpr size_t OFF_WGT = 13 * MiB;
constexpr size_t OFF_WPT = 15 * MiB;
constexpr size_t OFF_WLT = 15 * MiB + 512 * 1024;
constexpr size_t OFF_SUBK = 16 * MiB + 512 * 1024;
constexpr size_t OFF_ROPE = 17 * MiB;
constexpr size_t OFF_CTR = 19 * MiB;
constexpr size_t OFF_ACT = 20 * MiB;
constexpr size_t OFF_QK = 84 * MiB;
constexpr size_t OFF_VT = 148 * MiB;
constexpr size_t OFF_ZRW = 180 * MiB;
constexpr size_t OFF_V = 292 * MiB;
constexpr size_t OFF_AL = 356 * MiB;
constexpr size_t OFF_DD = 420 * MiB;
constexpr size_t OFF_L16 = 388 * MiB;
constexpr size_t OFF_PM = 100 * MiB;
constexpr size_t OFF_HM = 132 * MiB;
constexpr size_t OFF_BE = 180 * MiB;
constexpr size_t OFF_G16 = 244 * MiB;
constexpr size_t OFF_Q16 = 84 * MiB;
constexpr size_t OFF_ST = 148 * MiB;
constexpr size_t OFF_IDX = 276 * MiB;
constexpr size_t OFF_GATE = 292 * MiB;
constexpr size_t OFF_PU16 = 308 * MiB;
constexpr size_t OFF_PV16 = 340 * MiB;
constexpr size_t OFF_P16 = 468 * MiB;

struct Params {
  const float *x, *p; const int* pos;
  const float *norm_mix_g, *w_in, *lam_q1, *lam_k1, *lam_q2, *lam_k2, *subln_g;
  const float *rw_mu, *rw_w0, *rw_w_up, *rw_a0, *rw_a_up, *rw_g_up, *rw_k_k, *rw_k_a, *rw_r_k, *rw_ln_g, *rw_ln_b;
  const float *w_out, *norm_ffn_g, *peer_w_q, *peer_sub_keys, *peer_u, *peer_v, *norm_ple_g, *ple_gate_w, *ple_proj_w, *norm_final_g;
  float* out; char* ws;
  float inv_freq[8];
  int ph_lo, ph_hi;
};

DI u32 pack2(float a, float b) { f32x2 v = {a, b}; bf16x2 r = __builtin_convertvector(v, bf16x2); return __builtin_bit_cast(u32, r); }
DI u16 f2bf(float a) { return (u16)(pack2(a, 0.f) & 0xffffu); }
DI float bflo(u32 v) { return __uint_as_float(v << 16); }
DI float bfhi(u32 v) { return __uint_as_float(v & 0xffff0000u); }
DI f32x16 mfma32(bf16x8 a, bf16x8 b, f32x16 c) { return __builtin_amdgcn_mfma_f32_32x32x16_bf16(a, b, c, 0, 0, 0); }
DI int crow(int i, int h) { return (i & 3) + 8 * (i >> 2) + 4 * h; }
template <int CTRL> DI float dppf(float x) { return __int_as_float(__builtin_amdgcn_update_dpp(0, __float_as_int(x), CTRL, 0xf, 0xf, false)); }
DI float sum8(float x) { x += dppf<0xB1>(x); x += dppf<0x4E>(x); x += dppf<0x141>(x); return x; }
DI float rlf(float x, int l) { return __int_as_float(__builtin_amdgcn_readlane(__float_as_int(x), l)); }
DI float wave_sum(float x) {
  x = sum8(x); x += dppf<0x140>(x);
  return (rlf(x, 0) + rlf(x, 16)) + (rlf(x, 32) + rlf(x, 48));
}
DI float xor32(float x) { return __shfl_xor(x, 32); }
DI cfptr to_const(const float* p) { return (cfptr)(uintptr_t)p; }
DI float sigmoidf_(float x) { return 1.f / (1.f + __expf(-x)); }
DI float dot8(u32x4 a, u32x4 b, float acc) {
  acc = fmaf(bflo(a.x), bflo(b.x), acc); acc = fmaf(bfhi(a.x), bfhi(b.x), acc);
  acc = fmaf(bflo(a.y), bflo(b.y), acc); acc = fmaf(bfhi(a.y), bfhi(b.y), acc);
  acc = fmaf(bflo(a.z), bflo(b.z), acc); acc = fmaf(bfhi(a.z), bfhi(b.z), acc);
  acc = fmaf(bflo(a.w), bflo(b.w), acc); acc = fmaf(bfhi(a.w), bfhi(b.w), acc);
  return acc;
}

constexpr int LDS_LD = 72;
constexpr int G_BUF = 2 * 128 * LDS_LD;
DI void gemm_tile(f32x16 (&acc)[2][2], const u16* Wt, int ldw, const u16* X, int ldx, int K, u16* sW, u16* sX) {
  const int tid = threadIdx.x, lane = tid & 63, wave = tid >> 6;
  const int wn = wave >> 1, wm = wave & 1, r = lane & 31, h = lane >> 5;
  const u16* gw = Wt + (size_t)(tid >> 3) * ldw + (tid & 7) * 8;
  const u16* gx = X + (size_t)(tid >> 3) * ldx + (tid & 7) * 8;
  u16* lw = sW + (tid >> 3) * LDS_LD + (tid & 7) * 8;
  u16* lx = sX + (tid >> 3) * LDS_LD + (tid & 7) * 8;
  const size_t sw32 = (size_t)32 * ldw, sx32 = (size_t)32 * ldx;
  const u16* pa = sW + (wn * 64 + r) * LDS_LD + h * 8;
  const u16* pb = sX + (wm * 64 + r) * LDS_LD + h * 8;
  const int nk = K >> 6;
  u32x4 r0w[4], r0x[4], r1w[4], r1x[4];
#define G_LOAD(RW, RX, kt) { _Pragma("unroll") for (int i = 0; i < 4; ++i) { RW[i] = *(const u32x4*)(gw + i * sw32 + (kt) * 64); RX[i] = *(const u32x4*)(gx + i * sx32 + (kt) * 64); } }
#define G_STORE(RW, RX, st) { _Pragma("unroll") for (int i = 0; i < 4; ++i) { *(u32x4*)(lw + (st) * G_BUF + i * 32 * LDS_LD) = RW[i]; *(u32x4*)(lx + (st) * G_BUF + i * 32 * LDS_LD) = RX[i]; } }
#define G_COMPUTE(st) { _Pragma("unroll") for (int ks = 0; ks < 4; ++ks) { bf16x8 a[2], b[2]; \
    _Pragma("unroll") for (int i = 0; i < 2; ++i) { a[i] = *(const bf16x8*)(pa + (st) * G_BUF + i * 32 * LDS_LD + ks * 16); b[i] = *(const bf16x8*)(pb + (st) * G_BUF + i * 32 * LDS_LD + ks * 16); } \
    _Pragma("unroll") for (int i = 0; i < 2; ++i) _Pragma("unroll") for (int jj = 0; jj < 2; ++jj) acc[i][jj] = mfma32(a[i], b[jj], acc[i][jj]); } }
  G_LOAD(r0w, r0x, 0)
  __syncthreads();
  G_STORE(r0w, r0x, 0)
  G_LOAD(r0w, r0x, 1)
  if (nk > 2) G_LOAD(r1w, r1x, 2)
  __syncthreads();
  for (int k = 0; k < nk; k += 2) {
    __builtin_amdgcn_s_setprio(1); G_COMPUTE(0) __builtin_amdgcn_s_setprio(0);
    G_STORE(r0w, r0x, 1)
    if (k + 3 < nk) G_LOAD(r0w, r0x, k + 3)
    __syncthreads();
    __builtin_amdgcn_s_setprio(1); G_COMPUTE(1) __builtin_amdgcn_s_setprio(0);
    if (k + 2 < nk) {
      G_STORE(r1w, r1x, 0)
      if (k + 4 < nk) G_LOAD(r1w, r1x, k + 4)
      __syncthreads();
    }
  }
#undef G_LOAD
#undef G_STORE
#undef G_COMPUTE
}
DI void zero_acc(f32x16 (&acc)[2][2]) {
#pragma unroll
  for (int i = 0; i < 2; ++i)
#pragma unroll
    for (int j = 0; j < 2; ++j)
#pragma unroll
      for (int k = 0; k < 16; ++k) acc[i][j][k] = 0.f;
}

DI void transpose_tile(const float* src, int N, int kt, int nt, u16* dst, int ldd, int kofs, bool valid, float* tile) {
  const int tid = threadIdx.x;
  if (valid) {
#pragma unroll 4
    for (int i = 0; i < 16; ++i) {
      int idx = tid + 256 * i, kk = idx >> 6, nn = idx & 63;
      tile[kk * 65 + nn] = src[(size_t)(kt * 64 + kk) * N + nt * 64 + nn];
    }
  }
  __syncthreads();
#pragma unroll 4
  for (int i = 0; i < 16; ++i) {
    int idx = tid + 256 * i, nn = idx >> 6, kk = idx & 63;
    float v = valid ? tile[kk * 65 + nn] : 0.f;
    dst[(size_t)(nt * 64 + nn) * ldd + kofs + kt * 64 + kk] = f2bf(v);
  }
  __syncthreads();
}
DI void transpose_all(const float* src, int K, int N, u16* dst, float* tile) {
  int KT = K / 64, NTt = N / 64;
  for (int t = blockIdx.x; t < KT * NTt; t += gridDim.x) transpose_tile(src, N, t % KT, t / KT, dst, K, 0, true, tile);
}
DI void convert_flat(const float* src, u16* dst, size_t n) {
  size_t n4 = n / 4;
  for (size_t i = (size_t)blockIdx.x * 256 + threadIdx.x; i < n4; i += (size_t)gridDim.x * 256) {
    float4 v = ((const float4*)src)[i];
    u32x2 o = {pack2(v.x, v.y), pack2(v.z, v.w)};
    ((u32x2*)dst)[i] = o;
  }
}
DI void convert_fp8(const float* src, unsigned char* dst, size_t n, float scale) {
  size_t n8 = n / 8;
  for (size_t i = (size_t)blockIdx.x * 256 + threadIdx.x; i < n8; i += (size_t)gridDim.x * 256) {
    float4 a = ((const float4*)src)[2 * i], b = ((const float4*)src)[2 * i + 1];
    int r0 = __builtin_amdgcn_cvt_pk_fp8_f32(a.x * scale, a.y * scale, 0, false);
    r0 = __builtin_amdgcn_cvt_pk_fp8_f32(a.z * scale, a.w * scale, r0, true);
    int r1 = __builtin_amdgcn_cvt_pk_fp8_f32(b.x * scale, b.y * scale, 0, false);
    r1 = __builtin_amdgcn_cvt_pk_fp8_f32(b.z * scale, b.w * scale, r1, true);
    u32x2 o = {(u32)r0, (u32)r1};
    ((u32x2*)dst)[i] = o;
  }
}
DI void convert_fp4(const float* src, unsigned char* dst, size_t n, float scale) {
  size_t n8 = n / 8;
  for (size_t i = (size_t)blockIdx.x * 256 + threadIdx.x; i < n8; i += (size_t)gridDim.x * 256) {
    float4 a = ((const float4*)src)[2 * i], b = ((const float4*)src)[2 * i + 1];
    u32 r = 0u;
    r = __builtin_amdgcn_cvt_scalef32_pk_fp4_f32(r, a.x * scale, a.y * scale, 1.0f, 0);
    r = __builtin_amdgcn_cvt_scalef32_pk_fp4_f32(r, a.z * scale, a.w * scale, 1.0f, 1);
    r = __builtin_amdgcn_cvt_scalef32_pk_fp4_f32(r, b.x * scale, b.y * scale, 1.0f, 2);
    r = __builtin_amdgcn_cvt_scalef32_pk_fp4_f32(r, b.z * scale, b.w * scale, 1.0f, 3);
    ((u32*)dst)[i] = r;
  }
}
DI void fp4x8_to_f32(u32 w, float* f) {
  f32x2 p0 = __builtin_amdgcn_cvt_scalef32_pk_f32_fp4(w, 1.0f, 0), p1 = __builtin_amdgcn_cvt_scalef32_pk_f32_fp4(w, 1.0f, 1);
  f32x2 p2 = __builtin_amdgcn_cvt_scalef32_pk_f32_fp4(w, 1.0f, 2), p3 = __builtin_amdgcn_cvt_scalef32_pk_f32_fp4(w, 1.0f, 3);
  f[0] = p0.x; f[1] = p0.y; f[2] = p1.x; f[3] = p1.y; f[4] = p2.x; f[5] = p2.y; f[6] = p3.x; f[7] = p3.y;
}
DI u32 pack_fp4x8(const float4 a, const float4 b, float scale) {
  u32 r = 0u;
  r = __builtin_amdgcn_cvt_scalef32_pk_fp4_f32(r, a.x * scale, a.y * scale, 1.0f, 0);
  r = __builtin_amdgcn_cvt_scalef32_pk_fp4_f32(r, a.z * scale, a.w * scale, 1.0f, 1);
  r = __builtin_amdgcn_cvt_scalef32_pk_fp4_f32(r, b.x * scale, b.y * scale, 1.0f, 2);
  r = __builtin_amdgcn_cvt_scalef32_pk_fp4_f32(r, b.z * scale, b.w * scale, 1.0f, 3);
  return r;
}
DI void convert_uv_fp4(const float* u, const float* v, unsigned char* dst, float su, float sv) {
  const size_t n = (size_t)16384 * 64;
  for (size_t i = (size_t)blockIdx.x * 256 + threadIdx.x; i < n; i += (size_t)gridDim.x * 256) {
    const float4* pu = (const float4*)(u + i * 16); const float4* pv = (const float4*)(v + i * 16);
    u32x4 o = {pack_fp4x8(pu[0], pu[1], su), pack_fp4x8(pu[2], pu[3], su), pack_fp4x8(pv[0], pv[1], sv), pack_fp4x8(pv[2], pv[3], sv)};
    ((u32x4*)dst)[i] = o;
  }
}
DI void rmsnorm_rows(const float* src, const float* g, u16* dst) {
  const int lane = threadIdx.x & 63, wave = threadIdx.x >> 6;
  for (int t = blockIdx.x * 4 + wave; t < T_; t += gridDim.x * 4) {
    const float4* row = (const float4*)(src + (size_t)t * 1024);
    float4 v[4]; float ss = 0.f;
#pragma unroll
    for (int i = 0; i < 4; ++i) { v[i] = row[lane + 64 * i]; ss += v[i].x * v[i].x + v[i].y * v[i].y + v[i].z * v[i].z + v[i].w * v[i].w; }
    ss = wave_sum(ss);
    float rs = rsqrtf(ss * (1.f / 1024.f) + 1e-6f);
#pragma unroll
    for (int i = 0; i < 4; ++i) {
      float4 gg = ((const float4*)g)[lane + 64 * i];
      u32x2 o = {pack2(v[i].x * rs * gg.x, v[i].y * rs * gg.y), pack2(v[i].z * rs * gg.z, v[i].w * rs * gg.w)};
      ((u32x2*)(dst + (size_t)t * 1024))[lane + 64 * i] = o;
    }
  }
}
DI void phase_prep(const Params& P, char* smem) {
  float* tile = (float*)smem;
  char* ws = P.ws;
  transpose_all(P.w_in, 1024, 3328, (u16*)(ws + OFF_WINT), tile);
  transpose_all(P.w_out, 1024, 1024, (u16*)(ws + OFF_WOUTT), tile);
  transpose_all(P.peer_w_q, 1024, 2048, (u16*)(ws + OFF_WQT), tile);
  transpose_all(P.ple_gate_w, 1024, 1024, (u16*)(ws + OFF_WGT), tile);
  transpose_all(P.ple_proj_w, 256, 1024, (u16*)(ws + OFF_WPT), tile);
  for (int t = blockIdx.x; t < 24 * 4; t += gridDim.x) {
    int nt = t >> 2, kt = t & 3, sec = nt >> 3, ntl = nt & 7;
    const float* src; int kts; bool valid;
    if (sec == 0) { src = P.rw_w_up; valid = (kt == 0); kts = 0; }
    else if (sec == 1) { src = P.rw_a_up; valid = (kt == 1); kts = 0; }
    else { src = P.rw_g_up; valid = (kt >= 2); kts = kt - 2; }
    transpose_tile(src, 512, kts, ntl, (u16*)(ws + OFF_WLT) + (size_t)sec * 512 * 256, 256, (kt - kts) * 64, valid, tile);
  }
  convert_flat(P.peer_sub_keys, (u16*)(ws + OFF_SUBK), (size_t)16 * 128 * 128);
  float2* rope = (float2*)(ws + OFF_ROPE);
  for (int i = blockIdx.x * 256 + threadIdx.x; i < T_ * 8; i += gridDim.x * 256) {
    int m = i >> 3, f = i & 7;
    float ang = (float)P.pos[m] * P.inv_freq[f];
    double a = (double)ang;
    double k = rint(a * 0.15915494309189535);
    float rr = (float)(a - k * 6.283185307179586);
    rope[i] = make_float2(__cosf(rr), __sinf(rr));
  }
  rmsnorm_rows(P.x, P.norm_mix_g, (u16*)(ws + OFF_ACT));
}

DI void phase_gemm1(const Params& P, char* smem) {
  u16* sW = (u16*)smem; u16* sX = sW + 128 * LDS_LD;
  char* ws = P.ws;
  const u16* WinT = (const u16*)(ws + OFF_WINT); const u16* ACT = (const u16*)(ws + OFF_ACT);
  const float2* rope = (const float2*)(ws + OFF_ROPE);
  u16* QK = (u16*)(ws + OFF_QK); u16* VT = (u16*)(ws + OFF_VT); u16* ZRW = (u16*)(ws + OFF_ZRW);
  const int lane = threadIdx.x & 63, wave = threadIdx.x >> 6, wn = wave >> 1, wm = wave & 1, r = lane & 31, h = lane >> 5;
  constexpr int NT = 26, MT = 256;
  for (int tile = blockIdx.x; tile < NT * MT; tile += gridDim.x) {
    int mt = tile / NT, nt = tile % NT;
    f32x16 acc[2][2]; zero_acc(acc);
    gemm_tile(acc, WinT + (size_t)nt * 128 * 1024, 1024, ACT + (size_t)mt * 128 * 1024, 1024, 1024, sW, sX);
#pragma unroll
    for (int ai = 0; ai < 2; ++ai)
#pragma unroll
      for (int bi = 0; bi < 2; ++bi) {
        const int nb = nt * 128 + wn * 64 + ai * 32;
        const int m = mt * 128 + wm * 64 + bi * 32 + r;
        f32x16 v = acc[ai][bi];
        if (nb < 1024) {
          if ((nb & 63) == 0) {
#pragma unroll
            for (int i = 0; i < 4; ++i) {
              float2 cs = rope[m * 8 + 4 * h + i];
              float t1 = v[i], t2 = v[i + 4];
              v[i] = t1 * cs.x - t2 * cs.y; v[i + 4] = t2 * cs.x + t1 * cs.y;
            }
          }
          if (nb < 512) {
#pragma unroll
            for (int i = 0; i < 16; ++i) v[i] *= 0.125f;
          }
#pragma unroll
          for (int q = 0; q < 4; ++q) {
            u32x2 pk = {pack2(v[4 * q], v[4 * q + 1]), pack2(v[4 * q + 2], v[4 * q + 3])};
            *(u32x2*)(QK + (size_t)m * 1024 + nb + 8 * q + 4 * h) = pk;
          }
        } else if (nb < 1536) {
          const int hh = (nb - 1024) >> 7, dv0 = (nb - 1024) & 127, b = m >> 13, s = m & 8191;
#pragma unroll
          for (int i = 0; i < 16; ++i) VT[((size_t)((b * 4 + hh) * 128 + dv0 + crow(i, h))) * S_ + s] = f2bf(v[i]);
        } else {
#pragma unroll
          for (int q = 0; q < 4; ++q) {
            u32x2 pk = {pack2(v[4 * q], v[4 * q + 1]), pack2(v[4 * q + 2], v[4 * q + 3])};
            *(u32x2*)(ZRW + (size_t)m * 1792 + (nb - 1536) + 8 * q + 4 * h) = pk;
          }
        }
      }
  }
}

DI void phase_attn(const Params& P, char* smem) {
  constexpr int ATT_BUF = (64 + 128) * LDS_LD;
  u16* sK = (u16*)smem;
  u16* sV = sK + 64 * LDS_LD;
  int* sItem = (int*)(sK + 2 * ATT_BUF);
  char* ws = P.ws;
  const u16* QK = (const u16*)(ws + OFF_QK); const u16* VT = (const u16*)(ws + OFF_VT);
  u16* CAT = (u16*)(ws + OFF_ACT);
  unsigned* ctr = (unsigned*)(ws + OFF_CTR);
  const int tid = threadIdx.x, lane = tid & 63, wave = tid >> 6, r = lane & 31, h = lane >> 5;
  float d1 = 0.f, d2 = 0.f;
  for (int i = 0; i < 64; ++i) { d1 += P.lam_q1[i] * P.lam_k1[i]; d2 += P.lam_q2[i] * P.lam_k2[i]; }
  const float lam = expf(d1) - expf(d2) + 0.2f;
  const float LOG2E = 1.4426950408889634f;
  for (;;) {
    __syncthreads();
    if (tid == 0) *sItem = (int)atomicAdd(ctr, 1u);
    __syncthreads();
    const int item = *sItem;
    if (item >= 1024) break;
    const int qt = 63 - (item >> 4), bh = item & 15, b = bh >> 2, hh = bh & 3;
    const int qlo = qt * 128 + wave * 32;
    const size_t mq = (size_t)b * S_ + qlo + r;
    const int ntiles = 2 * qt + 2;
    float4* scr = (float4*)(ws + 324 * MiB) + (size_t)blockIdx.x * 16 * 256 + tid;
#pragma unroll
    for (int c = 0; c < 2; ++c) {
      bf16x8 qf[4];
#pragma unroll
      for (int ks = 0; ks < 4; ++ks) qf[ks] = *(const bf16x8*)(QK + mq * 1024 + hh * 128 + c * 64 + ks * 16 + h * 8);
      f32x16 o[4];
#pragma unroll
      for (int d = 0; d < 4; ++d)
#pragma unroll
        for (int i = 0; i < 16; ++i) o[d][i] = 0.f;
      float mrow = -1e30f, lsum = 0.f;
      const u16* kbase = QK + ((size_t)b * S_) * 1024 + 512 + hh * 128 + c * 64;
      const u16* vbase = VT + ((size_t)(b * 4 + hh) * 128) * S_;
      u32x4 rk[2], rv[4];
#pragma unroll
      for (int i = 0; i < 2; ++i) { int cc = tid + 256 * i, row = cc >> 3, kc = cc & 7; rk[i] = *(const u32x4*)(kbase + (size_t)row * 1024 + kc * 8); }
#pragma unroll
      for (int i = 0; i < 4; ++i) { int cc = tid + 256 * i, row = cc >> 3, kc = cc & 7; rv[i] = *(const u32x4*)(vbase + (size_t)row * S_ + kc * 8); }
      __syncthreads();
#pragma unroll
      for (int i = 0; i < 2; ++i) { int cc = tid + 256 * i, row = cc >> 3, kc = cc & 7; *(u32x4*)(sK + row * LDS_LD + kc * 8) = rk[i]; }
#pragma unroll
      for (int i = 0; i < 4; ++i) { int cc = tid + 256 * i, row = cc >> 3, kc = cc & 7; *(u32x4*)(sV + row * LDS_LD + kc * 8) = rv[i]; }
      __syncthreads();
      for (int j = 0; j < ntiles; ++j) {
        const int cur = j & 1;
        const u16* sKc = sK + cur * ATT_BUF; const u16* sVc = sV + cur * ATT_BUF;
        u16* sKn = sK + (cur ^ 1) * ATT_BUF; u16* sVn = sV + (cur ^ 1) * ATT_BUF;
        const bool more = (j + 1 < ntiles);
        if (more) {
          const int k0 = (j + 1) * 64;
#pragma unroll
          for (int i = 0; i < 2; ++i) { int cc = tid + 256 * i, row = cc >> 3, kc = cc & 7; rk[i] = *(const u32x4*)(kbase + (size_t)(k0 + row) * 1024 + kc * 8); }
#pragma unroll
          for (int i = 0; i < 4; ++i) { int cc = tid + 256 * i, row = cc >> 3, kc = cc & 7; rv[i] = *(const u32x4*)(vbase + (size_t)row * S_ + k0 + kc * 8); }
        }
        f32x16 st[2];
        float mnew = 0.f;
        const int key0 = j * 64;
        if (key0 <= qlo + 31) {
          __builtin_amdgcn_s_setprio(1);
#pragma unroll
          for (int kb = 0; kb < 2; ++kb) {
#pragma unroll
            for (int i = 0; i < 16; ++i) st[kb][i] = 0.f;
#pragma unroll
            for (int ks = 0; ks < 4; ++ks) {
              bf16x8 kf = *(const bf16x8*)(sKc + (kb * 32 + r) * LDS_LD + ks * 16 + h * 8);
              st[kb] = mfma32(kf, qf[ks], st[kb]);
            }
          }
          __builtin_amdgcn_s_setprio(0);
          const bool need_mask = (key0 + 63 > qlo);
          float mx = -1e30f;
#pragma unroll
          for (int kb = 0; kb < 2; ++kb)
#pragma unroll
            for (int i = 0; i < 16; ++i) {
              float s = st[kb][i] * LOG2E;
              if (need_mask) { int key = key0 + kb * 32 + crow(i, h); if (key > qlo + r) s = -1e30f; }
              st[kb][i] = s; mx = fmaxf(mx, s);
            }
          mx = fmaxf(mx, xor32(mx));
          mnew = fmaxf(mrow, mx);
          const float alpha = __builtin_amdgcn_exp2f(mrow - mnew);
          mrow = mnew;
          float ps = 0.f;
#pragma unroll
          for (int kb = 0; kb < 2; ++kb)
#pragma unroll
            for (int i = 0; i < 16; ++i) { float p = __builtin_amdgcn_exp2f(st[kb][i] - mnew); st[kb][i] = p; ps += p; }
          lsum = lsum * alpha + ps;
#pragma unroll
          for (int d = 0; d < 4; ++d)
#pragma unroll
            for (int i = 0; i < 16; ++i) o[d][i] *= alpha;
        }
        if (more) {
#pragma unroll
          for (int i = 0; i < 2; ++i) { int cc = tid + 256 * i, row = cc >> 3, kc = cc & 7; *(u32x4*)(sKn + row * LDS_LD + kc * 8) = rk[i]; }
#pragma unroll
          for (int i = 0; i < 4; ++i) { int cc = tid + 256 * i, row = cc >> 3, kc = cc & 7; *(u32x4*)(sVn + row * LDS_LD + kc * 8) = rv[i]; }
        }
        if (key0 <= qlo + 31) {
          __builtin_amdgcn_s_setprio(1);
#pragma unroll
          for (int kb = 0; kb < 2; ++kb)
#pragma unroll
            for (int s = 0; s < 2; ++s) {
              u32x4 pp = {pack2(st[kb][8 * s], st[kb][8 * s + 1]), pack2(st[kb][8 * s + 2], st[kb][8 * s + 3]),
                          pack2(st[kb][8 * s + 4], st[kb][8 * s + 5]), pack2(st[kb][8 * s + 6], st[kb][8 * s + 7])};
              bf16x8 pf = __builtin_bit_cast(bf16x8, pp);
#pragma unroll
              for (int d = 0; d < 4; ++d) {
                const u16* vp = sVc + (d * 32 + r) * LDS_LD + kb * 32 + 16 * s + 4 * h;
                s16x4 lo = *(const s16x4*)vp, hi = *(const s16x4*)(vp + 8);
                bf16x8 vf = __builtin_shufflevector(lo, hi, 0, 1, 2, 3, 4, 5, 6, 7);
                o[d] = mfma32(vf, pf, o[d]);
              }
            }
          __builtin_amdgcn_s_setprio(0);
        }
        __syncthreads();
      }
      const float ltot = lsum + xor32(lsum);
      const float inv = 1.f / ltot;
      if (c == 0) {
#pragma unroll
        for (int d = 0; d < 4; ++d)
#pragma unroll
          for (int q = 0; q < 4; ++q) scr[(d * 4 + q) * 256] = make_float4(o[d][4 * q] * inv, o[d][4 * q + 1] * inv, o[d][4 * q + 2] * inv, o[d][4 * q + 3] * inv);
      } else {
        float ss = 0.f;
        const float li = lam * inv;
#pragma unroll
        for (int d = 0; d < 4; ++d)
#pragma unroll
          for (int q = 0; q < 4; ++q) {
            float4 p0 = scr[(d * 4 + q) * 256];
            float v0 = p0.x - li * o[d][4 * q], v1 = p0.y - li * o[d][4 * q + 1], v2 = p0.z - li * o[d][4 * q + 2], v3 = p0.w - li * o[d][4 * q + 3];
            o[d][4 * q] = v0; o[d][4 * q + 1] = v1; o[d][4 * q + 2] = v2; o[d][4 * q + 3] = v3;
            ss += v0 * v0 + v1 * v1 + v2 * v2 + v3 * v3;
          }
        ss += xor32(ss);
        const float rs = rsqrtf(ss * (1.f / 128.f) + 1e-6f) * 0.8f;
#pragma unroll
        for (int d = 0; d < 4; ++d)
#pragma unroll
          for (int q = 0; q < 4; ++q) {
            const int dv = d * 32 + 8 * q + 4 * h;
            float4 g = *(const float4*)(P.subln_g + dv);
            u32x2 pk = {pack2(o[d][4 * q] * rs * g.x, o[d][4 * q + 1] * rs * g.y), pack2(o[d][4 * q + 2] * rs * g.z, o[d][4 * q + 3] * rs * g.w)};
            *(u32x2*)(CAT + mq * 1024 + hh * 128 + dv) = pk;
          }
      }
    }
  }
}

DI void load8(const u16* p, float (&f)[8]) {
  u32x4 v = *(const u32x4*)p;
  f[0] = bflo(v.x); f[1] = bfhi(v.x); f[2] = bflo(v.y); f[3] = bfhi(v.y); f[4] = bflo(v.z); f[5] = bfhi(v.z); f[6] = bflo(v.w); f[7] = bfhi(v.w);
}
DI void shift8(const u16* zc, bool first, const float* mu, float (&z)[8]) {
  float c[8], p[8];
  load8(zc, c);
  if (first) { for (int e = 0; e < 8; ++e) p[e] = 0.f; } else load8(zc - 1792, p);
  float4 m0 = *(const float4*)mu, m1 = *(const float4*)(mu + 4);
  float mm[8] = {m0.x, m0.y, m0.z, m0.w, m1.x, m1.y, m1.z, m1.w};
#pragma unroll
  for (int e = 0; e < 8; ++e) z[e] = c[e] + (p[e] - c[e]) * mm[e];
}
DI void store8h(u16* dst, const float (&z)[8]) {
  u32x4 o = {pack2(z[0], z[1]), pack2(z[2], z[3]), pack2(z[4], z[5]), pack2(z[6], z[7])};
  *(u32x4*)dst = o;
}
DI void store8f(float* dst, const float (&z)[8]) {
  *(float4*)dst = make_float4(z[0], z[1], z[2], z[3]); *(float4*)(dst + 4) = make_float4(z[4], z[5], z[6], z[7]);
}
DI void phase_rwprep(const Params& P) {
  char* ws = P.ws;
  const u16* ZRW = (const u16*)(ws + OFF_ZRW);
  u16* Rb = (u16*)P.out; u16* Kb = (u16*)P.out + (size_t)T_ * 512;
  u16* Vb = (u16*)(ws + OFF_V); u16* ALb = (u16*)(ws + OFF_AL); u16* L16 = (u16*)(ws + OFF_L16);
  const int lane = threadIdx.x & 63, wave = threadIdx.x >> 6;
  for (int t = blockIdx.x * 4 + wave; t < T_; t += gridDim.x * 4) {
    const bool first = (t & (S_ - 1)) == 0;
    const u16* zc = ZRW + (size_t)t * 1792;
    float z[8];
    shift8(zc + lane * 8, first, P.rw_mu + lane * 8, z);
    store8h(Rb + (size_t)t * 512 + lane * 8, z);
    shift8(zc + 512 + lane * 8, first, P.rw_mu + 512 + lane * 8, z);
    store8h(Kb + (size_t)t * 512 + lane * 8, z);
    {
      float4 k0 = *(const float4*)(P.rw_k_k + lane * 8), k1 = *(const float4*)(P.rw_k_k + lane * 8 + 4);
      float kk[8] = {z[0] * k0.x, z[1] * k0.y, z[2] * k0.z, z[3] * k0.w, z[4] * k1.x, z[5] * k1.y, z[6] * k1.z, z[7] * k1.w};
      float ss = 0.f;
#pragma unroll
      for (int e = 0; e < 8; ++e) ss += kk[e] * kk[e];
      ss = sum8(ss);
      float inv = -1.f / fmaxf(sqrtf(ss), 1e-12f);
#pragma unroll
      for (int e = 0; e < 8; ++e) kk[e] *= inv;
      store8h(ALb + (size_t)t * 512 + lane * 8, kk);
    }
    shift8(zc + 1024 + lane * 8, first, P.rw_mu + 1024 + lane * 8, z);
    store8h(Vb + (size_t)t * 512 + lane * 8, z);
    if (lane < 32) {
      shift8(zc + 1536 + lane * 8, first, P.rw_mu + 1536 + lane * 8, z);
      if (lane < 8) { for (int e = 0; e < 8; ++e) z[e] = tanhf(z[e]); }
      else if (lane >= 16) { for (int e = 0; e < 8; ++e) z[e] = sigmoidf_(z[e]); }
      u32x4 o = {pack2(z[0], z[1]), pack2(z[2], z[3]), pack2(z[4], z[5]), pack2(z[6], z[7])};
      *(u32x4*)(L16 + (size_t)t * 256 + lane * 8) = o;
    }
  }
}

DI void phase_lora(const Params& P, char* smem) {
  u16* sW = (u16*)smem; u16* sX = sW + 128 * LDS_LD;
  char* ws = P.ws;
  const u16* WlT = (const u16*)(ws + OFF_WLT); const u16* L16 = (const u16*)(ws + OFF_L16);
  u16* Kb = (u16*)P.out + (size_t)T_ * 512; const u16* ALb = (const u16*)(ws + OFF_AL);
  u16* BEb = (u16*)(ws + OFF_BE); float* DDb = (float*)(ws + OFF_DD); u16* G16 = (u16*)(ws + OFF_G16);
  const int lane = threadIdx.x & 63, wave = threadIdx.x >> 6, wn = wave >> 1, wm = wave & 1, r = lane & 31, h = lane >> 5;
  constexpr int NT = 12, MT = 256;
  for (int tile = blockIdx.x; tile < NT * MT; tile += gridDim.x) {
    int mt = tile / NT, nt = tile % NT;
    f32x16 acc[2][2]; zero_acc(acc);
    gemm_tile(acc, WlT + (size_t)nt * 128 * 256, 256, L16 + (size_t)mt * 128 * 256, 256, 256, sW, sX);
#pragma unroll
    for (int ai = 0; ai < 2; ++ai)
#pragma unroll
      for (int bi = 0; bi < 2; ++bi) {
        const int nb = nt * 128 + wn * 64 + ai * 32;
        const size_t m = mt * 128 + wm * 64 + bi * 32 + r;
        const f32x16 v = acc[ai][bi];
#pragma unroll
        for (int q = 0; q < 4; ++q) {
          const int ch = (nb & 511) + 8 * q + 4 * h;
          float a4[4] = {v[4 * q], v[4 * q + 1], v[4 * q + 2], v[4 * q + 3]};
          if (nb < 512) {
            float4 w0 = *(const float4*)(P.rw_w0 + ch);
            float ww[4] = {w0.x, w0.y, w0.z, w0.w}, dd[4];
#pragma unroll
            for (int e = 0; e < 4; ++e) {
              float xx = -(ww[e] + a4[e]);
              float sp = fmaxf(xx, 0.f) + log1pf(__expf(-fabsf(xx)));
              float w = -sp - 0.5f;
              dd[e] = __expf(-__expf(w));
            }
            *(float4*)(DDb + m * 512 + ch) = make_float4(dd[0], dd[1], dd[2], dd[3]);
          } else if (nb < 1024) {
            float4 a0 = *(const float4*)(P.rw_a0 + ch), ka = *(const float4*)(P.rw_k_a + ch);
            const u32x2 kvp = *(const u32x2*)(Kb + m * 512 + ch), alp = *(const u32x2*)(ALb + m * 512 + ch);
            const float kv[4] = {bflo(kvp.x), bfhi(kvp.x), bflo(kvp.y), bfhi(kvp.y)}, al[4] = {bflo(alp.x), bfhi(alp.x), bflo(alp.y), bfhi(alp.y)};
            float aa[4] = {sigmoidf_(a0.x + a4[0]), sigmoidf_(a0.y + a4[1]), sigmoidf_(a0.z + a4[2]), sigmoidf_(a0.w + a4[3])};
            u32x2 bo = {pack2(-al[0] * aa[0], -al[1] * aa[1]), pack2(-al[2] * aa[2], -al[3] * aa[3])};
            *(u32x2*)(BEb + m * 512 + ch) = bo;
            u32x2 ko = {pack2(kv[0] * (1.f + (aa[0] - 1.f) * ka.x), kv[1] * (1.f + (aa[1] - 1.f) * ka.y)),
                        pack2(kv[2] * (1.f + (aa[2] - 1.f) * ka.z), kv[3] * (1.f + (aa[3] - 1.f) * ka.w))};
            *(u32x2*)(Kb + m * 512 + ch) = ko;
          } else {
            u32x2 pk = {pack2(a4[0], a4[1]), pack2(a4[2], a4[3])};
            *(u32x2*)(G16 + m * 512 + ch) = pk;
          }
        }
      }
  }
}

constexpr int SC_TB = 8;
constexpr int SC_WLDS = 6 * SC_TB * 64;
template <int MODE>
DI void scan_chunk(const Params& P, int bh, int c, int lane, float* lds) {
  char* ws = P.ws;
  const int b = bh >> 3, h = bh & 7;
  const size_t tok0 = (size_t)b * S_ + (size_t)c * CH_L;
  const size_t base = tok0 * 512 + h * 64;
  const u16* arh[6] = {(const u16*)(ws + OFF_AL) + base, (const u16*)(ws + OFF_BE) + base, nullptr,
                       (const u16*)P.out + (size_t)T_ * 512 + base, (const u16*)P.out + base, (const u16*)(ws + OFF_V) + base};
  const float* ard = (const float*)(ws + OFF_DD) + base;
  float* PM = (float*)(ws + OFF_PM); float* HM = (float*)(ws + OFF_HM);
  f32x2 SA[32], SB[32];
  if (MODE == 0) {
#pragma unroll
    for (int p = 0; p < 32; ++p) { SA[p].x = (2 * p == lane) ? 1.f : 0.f; SA[p].y = (2 * p + 1 == lane) ? 1.f : 0.f; SB[p].x = 0.f; SB[p].y = 0.f; }
  } else if (c == 0) {
#pragma unroll
    for (int p = 0; p < 32; ++p) { SA[p].x = 0.f; SA[p].y = 0.f; }
  } else {
    const float4* src = (const float4*)(HM + ((size_t)(bh * CH_C + c - 1) * 64 + lane) * 64);
#pragma unroll
    for (int q = 0; q < 16; ++q) { float4 v = src[q]; SA[2 * q].x = v.x; SA[2 * q].y = v.y; SA[2 * q + 1].x = v.z; SA[2 * q + 1].y = v.w; }
  }
  float lng = 0.f, lnb = 0.f, rk = 0.f;
  const u16* G16 = (const u16*)(ws + OFF_G16) + base;
  u16* CAT = (u16*)(ws + OFF_ACT) + tok0 * 1024 + 512 + h * 64;
  if (MODE == 2) { lng = P.rw_ln_g[h * 64 + lane]; lnb = P.rw_ln_b[h * 64 + lane]; rk = P.rw_r_k[h * 64 + lane]; }
  const int st_t = lane >> 4, st_q = (lane & 15) * 4;
#pragma unroll 1
  for (int tb = 0; tb < CH_L / SC_TB; ++tb) {
    {
      u32x4 ph[6]; f32x4 pd[2];
#pragma unroll
      for (int a = 0; a < 6; ++a) {
        if (a == 2 || (MODE == 0 && a == 4)) continue;
        ph[a] = *(const u32x4*)(arh[a] + (size_t)(tb * SC_TB + (lane >> 3)) * 512 + (lane & 7) * 8);
      }
#pragma unroll
      for (int f = 0; f < 2; ++f) pd[f] = *(const f32x4*)(ard + (size_t)(tb * SC_TB + f * 4 + st_t) * 512 + st_q);
#pragma unroll
      for (int a = 0; a < 6; ++a) {
        if (a == 2 || (MODE == 0 && a == 4)) continue;
        float* dst = lds + (a * SC_TB + (lane >> 3)) * 64 + (lane & 7) * 8;
        f32x4 lo = {bflo(ph[a].x), bfhi(ph[a].x), bflo(ph[a].y), bfhi(ph[a].y)}, hi = {bflo(ph[a].z), bfhi(ph[a].z), bflo(ph[a].w), bfhi(ph[a].w)};
        *(f32x4*)dst = lo; *(f32x4*)(dst + 4) = hi;
      }
#pragma unroll
      for (int f = 0; f < 2; ++f) *(f32x4*)(lds + ((4 + f) * 64 + lane) * 4) = pd[f];
    }
#pragma unroll 1
    for (int t = 0; t < SC_TB; ++t) {
      const float* la = lds + t * 64;
      const float vi = la[5 * SC_TB * 64 + lane];
      float gbits = 0.f;
      if (MODE == 2) gbits = __uint_as_float((u32)G16[(size_t)(tb * SC_TB + t) * 512 + lane] << 16);
      f32x2 sa2 = {0.f, 0.f}, sb2 = {0.f, 0.f};
#pragma unroll
      for (int q = 0; q < 16; ++q) {
        if ((q & 3) == 0) asm volatile("" ::: "memory");
        const f32x4 al = *(const f32x4*)(la + 4 * q);
        const f32x2 al0 = {al.x, al.y}, al1 = {al.z, al.w};
        sa2 = SA[2 * q] * al0 + sa2; sa2 = SA[2 * q + 1] * al1 + sa2;
        if (MODE == 0) { sb2 = SB[2 * q] * al0 + sb2; sb2 = SB[2 * q + 1] * al1 + sb2; }
      }
      const float sa = sa2.x + sa2.y, sb = sb2.x + sb2.y;
      const f32x2 sav = {sa, sa}, sbv = {sb, sb}, viv = {vi, vi};
      f32x2 y2 = {0.f, 0.f};
#pragma unroll
      for (int q = 0; q < 16; ++q) {
        if ((q & 1) == 0) asm volatile("" ::: "memory");
        const f32x4 be = *(const f32x4*)(la + 1 * SC_TB * 64 + 4 * q);
        const f32x4 dd = *(const f32x4*)(la + 2 * SC_TB * 64 + 4 * q);
        const f32x4 kk = *(const f32x4*)(la + 3 * SC_TB * 64 + 4 * q);
        const f32x2 be0 = {be.x, be.y}, be1 = {be.z, be.w}, dd0 = {dd.x, dd.y}, dd1 = {dd.z, dd.w}, kk0 = {kk.x, kk.y}, kk1 = {kk.z, kk.w};
        if (MODE == 0) {
          SA[2 * q] = SA[2 * q] * dd0 + sav * be0; SA[2 * q + 1] = SA[2 * q + 1] * dd1 + sav * be1;
          SB[2 * q] = SB[2 * q] * dd0 + (viv * kk0 + sbv * be0); SB[2 * q + 1] = SB[2 * q + 1] * dd1 + (viv * kk1 + sbv * be1);
        } else {
          const f32x4 rr = *(const f32x4*)(la + 4 * SC_TB * 64 + 4 * q);
          const f32x2 rr0 = {rr.x, rr.y}, rr1 = {rr.z, rr.w};
          SA[2 * q] = SA[2 * q] * dd0 + (viv * kk0 + sav * be0); SA[2 * q + 1] = SA[2 * q + 1] * dd1 + (viv * kk1 + sav * be1);
          y2 = SA[2 * q] * rr0 + y2; y2 = SA[2 * q + 1] * rr1 + y2;
        }
      }
      if (MODE == 2) {
        const float y = y2.x + y2.y;
        const float rj = la[4 * SC_TB * 64 + lane], kj = la[3 * SC_TB * 64 + lane];
        const float mean = wave_sum(y) * (1.f / 64.f);
        const float dv = y - mean;
        const float var = wave_sum(dv * dv) * (1.f / 64.f);
        const float bonus = wave_sum(rj * kj * rk);
        float yn = dv * rsqrtf(var + 64e-5f) * lng + lnb;
        yn += bonus * vi;
        CAT[(size_t)(tb * SC_TB + t) * 1024 + lane] = f2bf(yn * gbits);
      }
    }
  }
  if (MODE == 0) {
    float4* dp = (float4*)(PM + ((size_t)(bh * CH_C + c) * 64 + lane) * 64);
    float4* dh = (float4*)(HM + ((size_t)(bh * CH_C + c) * 64 + lane) * 64);
#pragma unroll
    for (int q = 0; q < 16; ++q) {
      dp[q] = make_float4(SA[2 * q].x, SA[2 * q].y, SA[2 * q + 1].x, SA[2 * q + 1].y);
      dh[q] = make_float4(SB[2 * q].x, SB[2 * q].y, SB[2 * q + 1].x, SB[2 * q + 1].y);
    }
  }
}
DI void phase_scan1(const Params& P, char* smem) {
  const int lane = threadIdx.x & 63;
  const int wave = __builtin_amdgcn_readfirstlane((int)(threadIdx.x >> 6));
  float* lds = (float*)smem + wave * SC_WLDS;
  const int nitems = 32 * (CH_C - 1);
  for (int it = blockIdx.x * 4 + wave; it < nitems; it += gridDim.x * 4) scan_chunk<0>(P, it / (CH_C - 1), it % (CH_C - 1), lane, lds);
}
DI void phase_scan2(const Params& P, char* smem) {
  constexpr int SLD = 68;
  float* sA = (float*)smem;
  char* ws = P.ws;
  float* HM = (float*)(ws + OFF_HM); const float* PM = (const float*)(ws + OFF_PM);
  const int lane = threadIdx.x & 63, wave = threadIdx.x >> 6, ib = wave >> 1, jb = wave & 1, r = lane & 31, g = lane >> 5;
  for (int bh = blockIdx.x; bh < 32; bh += gridDim.x) {
    float av[32];
    {
      const float* s0 = HM + ((size_t)(bh * CH_C) * 64 + 32 * ib + r) * 64 + g;
#pragma unroll
      for (int kk = 0; kk < 32; ++kk) av[kk] = s0[2 * kk];
    }
#pragma unroll 1
    for (int c = 1; c <= CH_C - 2; ++c) {
      const float* pb = PM + ((size_t)(bh * CH_C + c) * 64 + g) * 64 + 32 * jb + r;
      float* hb = HM + ((size_t)(bh * CH_C + c) * 64 + 32 * ib + 4 * g) * 64 + 32 * jb + r;
      f32x16 acc;
#pragma unroll
      for (int q = 0; q < 16; ++q) acc[q] = hb[(size_t)((q & 3) + 8 * (q >> 2)) * 64];
      float bv[32];
#pragma unroll
      for (int kk = 0; kk < 32; ++kk) bv[kk] = pb[(size_t)(2 * kk) * 64];
#pragma unroll
      for (int kk = 0; kk < 32; ++kk) acc = __builtin_amdgcn_mfma_f32_32x32x2f32(av[kk], bv[kk], acc, 0, 0, 0);
      const int j = 32 * jb + r;
      __syncthreads();
#pragma unroll
      for (int q = 0; q < 16; ++q) {
        const int il = (q & 3) + 8 * (q >> 2) + 4 * g;
        hb[(size_t)((q & 3) + 8 * (q >> 2)) * 64] = acc[q];
        sA[(32 * ib + il) * SLD + (j & 1) * 32 + (j >> 1)] = acc[q];
      }
      __syncthreads();
#pragma unroll
      for (int k4 = 0; k4 < 8; ++k4) {
        const float4 v = *(const float4*)(sA + (32 * ib + r) * SLD + g * 32 + 4 * k4);
        av[4 * k4] = v.x; av[4 * k4 + 1] = v.y; av[4 * k4 + 2] = v.z; av[4 * k4 + 3] = v.w;
      }
    }
  }
}
DI void phase_scan3(const Params& P, char* smem) {
  const int lane = threadIdx.x & 63;
  const int wave = __builtin_amdgcn_readfirstlane((int)(threadIdx.x >> 6));
  float* lds = (float*)smem + wave * SC_WLDS;
  const int nitems = 32 * CH_C;
  for (int it = blockIdx.x * 4 + wave; it < nitems; it += gridDim.x * 4) scan_chunk<2>(P, it / CH_C, it % CH_C, lane, lds);
}

DI void phase_outproj(const Params& P, char* smem) {
  u16* sW = (u16*)smem; u16* sX = sW + 128 * LDS_LD;
  char* ws = P.ws;
  const u16* Wt = (const u16*)(ws + OFF_WOUTT); const u16* CAT = (const u16*)(ws + OFF_ACT);
  const int lane = threadIdx.x & 63, wave = threadIdx.x >> 6, wn = wave >> 1, wm = wave & 1, r = lane & 31, h = lane >> 5;
  constexpr int NT = 8, MT = 256;
  for (int tile = blockIdx.x; tile < NT * MT; tile += gridDim.x) {
    int mt = tile / NT, nt = tile % NT;
    f32x16 acc[2][2]; zero_acc(acc);
    gemm_tile(acc, Wt + (size_t)nt * 128 * 1024, 1024, CAT + (size_t)mt * 128 * 1024, 1024, 1024, sW, sX);
#pragma unroll
    for (int ai = 0; ai < 2; ++ai)
#pragma unroll
      for (int bi = 0; bi < 2; ++bi) {
        const int nb = nt * 128 + wn * 64 + ai * 32;
        const size_t m = mt * 128 + wm * 64 + bi * 32 + r;
#pragma unroll
        for (int q = 0; q < 4; ++q) {
          const int n = nb + 8 * q + 4 * h;
          float4 xv = *(const float4*)(P.x + m * 1024 + n);
          *(float4*)(P.out + m * 1024 + n) = make_float4(xv.x + acc[ai][bi][4 * q], xv.y + acc[ai][bi][4 * q + 1], xv.z + acc[ai][bi][4 * q + 2], xv.w + acc[ai][bi][4 * q + 3]);
        }
      }
  }
}

DI void phase_qproj(const Params& P, char* smem, int half) {
  u16* sW = (u16*)smem; u16* sX = sW + 128 * LDS_LD;
  char* ws = P.ws;
  const u16* Wt = (const u16*)(ws + OFF_WQT); const u16* A = (const u16*)(ws + OFF_ACT); u16* Q16 = (u16*)(ws + OFF_Q16);
  const int lane = threadIdx.x & 63, wave = threadIdx.x >> 6, wn = wave >> 1, wm = wave & 1, r = lane & 31, h = lane >> 5;
  constexpr int NT = 16, MT = 128;
  for (int tile = blockIdx.x; tile < NT * MT; tile += gridDim.x) {
    int mt = tile / NT, nt = tile % NT;
    f32x16 acc[2][2]; zero_acc(acc);
    gemm_tile(acc, Wt + (size_t)nt * 128 * 1024, 1024, A + (size_t)(half * 128 + mt) * 128 * 1024, 1024, 1024, sW, sX);
#pragma unroll
    for (int ai = 0; ai < 2; ++ai)
#pragma unroll
      for (int bi = 0; bi < 2; ++bi) {
        const int nb = nt * 128 + wn * 64 + ai * 32;
        const size_t m = mt * 128 + wm * 64 + bi * 32 + r;
#pragma unroll
        for (int q = 0; q < 4; ++q) {
          u32x2 pk = {pack2(acc[ai][bi][4 * q], acc[ai][bi][4 * q + 1]), pack2(acc[ai][bi][4 * q + 2], acc[ai][bi][4 * q + 3])};
          *(u32x2*)(Q16 + m * 2048 + nb + 8 * q + 4 * h) = pk;
        }
      }
  }
}
DI void phase_scores(const Params& P, char* smem) {
  u16* sW = (u16*)smem; u16* sX = sW + 128 * LDS_LD;
  char* ws = P.ws;
  const u16* SK = (const u16*)(ws + OFF_SUBK); const u16* Q16 = (const u16*)(ws + OFF_Q16); float* ST = (float*)(ws + OFF_ST);
  const int lane = threadIdx.x & 63, wave = threadIdx.x >> 6, wn = wave >> 1, wm = wave & 1, r = lane & 31, h = lane >> 5;
  for (int tile = blockIdx.x; tile < 16 * 128; tile += gridDim.x) {
    int mt = tile >> 4, hp = tile & 15;
    f32x16 acc[2][2]; zero_acc(acc);
    gemm_tile(acc, SK + (size_t)hp * 128 * 128, 128, Q16 + (size_t)mt * 128 * 2048 + hp * 128, 2048, 128, sW, sX);
#pragma unroll
    for (int ai = 0; ai < 2; ++ai)
#pragma unroll
      for (int bi = 0; bi < 2; ++bi) {
        const int nb = wn * 64 + ai * 32;
        const size_t m = mt * 128 + wm * 64 + bi * 32 + r;
#pragma unroll
        for (int i = 0; i < 16; ++i) ST[((size_t)(hp * 128 + nb + crow(i, h))) * TH_ + m] = acc[ai][bi][i];
      }
  }
}
DI u32 ford(float f) { u32 u = __float_as_uint(f); return u ^ ((u32)((int)u >> 31) | 0x80000000u); }
DI float funord(u32 k) { u32 u = (k & 0x80000000u) ? (k ^ 0x80000000u) : ~k; return __uint_as_float(u); }
DI void ins16(u32 (&L)[16], u32 x) {
#pragma unroll
  for (int k = 0; k < 16; ++k) { u32 hi = max(L[k], x); x = min(L[k], x); L[k] = hi; }
}
DI void phase_topk(const Params& P, int half) {
  char* ws = P.ws;
  const float* ST = (const float*)(ws + OFF_ST); int* IDX = (int*)(ws + OFF_IDX); float* GATE = (float*)(ws + OFF_GATE);
  const int lane = threadIdx.x & 63, wave = threadIdx.x >> 6;
  for (int it = blockIdx.x * 4 + wave; it < (TH_ / 64) * 8; it += gridDim.x * 4) {
    const int hd = it & 7, tl = (it >> 3) * 64 + lane, t = half * TH_ + tl;
    u32 L1[16], L2[16];
#pragma unroll
    for (int k = 0; k < 16; ++k) { L1[k] = 0u; L2[k] = 0u; }
    const float* s1 = ST + ((size_t)(hd * 2) * 128) * TH_ + tl;
    const float* s2 = ST + ((size_t)(hd * 2 + 1) * 128) * TH_ + tl;
#pragma unroll 8
    for (int n = 0; n < 128; ++n) {
      ins16(L1, (ford(s1[(size_t)n * TH_]) & ~127u) | (u32)(127 - n));
      ins16(L2, (ford(s2[(size_t)n * TH_]) & ~127u) | (u32)(127 - n));
    }
    float v1[16], v2[16];
#pragma unroll
    for (int k = 0; k < 16; ++k) { v1[k] = funord(L1[k] & ~127u); v2[k] = funord(L2[k] & ~127u); }
    u32 C[16];
#pragma unroll
    for (int k = 0; k < 16; ++k) C[k] = 0u;
#pragma unroll
    for (int a = 0; a < 16; ++a)
#pragma unroll
      for (int bb = 0; bb < 16; ++bb)
        if ((a + 1) * (bb + 1) <= 16) ins16(C, (ford(v1[a] + v2[bb]) & ~255u) | (u32)(255 - (a * 16 + bb)));
    float best[16]; float den = 0.f;
    const float m0 = funord(C[0] & ~255u);
#pragma unroll
    for (int k = 0; k < 16; ++k) { best[k] = __expf(funord(C[k] & ~255u) - m0); den += best[k]; }
    const float rden = 1.f / den;
#pragma unroll
    for (int k4 = 0; k4 < 4; ++k4) {
      int id[4];
#pragma unroll
      for (int u = 0; u < 4; ++u) {
        const int k = k4 * 4 + u;
        const int ab = 255 - (int)(C[k] & 255u), a = ab >> 4, bb = ab & 15;
        u32 e1 = 0, e2 = 0;
#pragma unroll
        for (int q = 0; q < 16; ++q) { e1 = (a == q) ? L1[q] : e1; e2 = (bb == q) ? L2[q] : e2; }
        id[u] = (127 - (int)(e1 & 127u)) * 128 + (127 - (int)(e2 & 127u));
      }
      *(int4*)(IDX + (size_t)t * 128 + hd * 16 + k4 * 4) = make_int4(id[0], id[1], id[2], id[3]);
      *(float4*)(GATE + (size_t)t * 128 + hd * 16 + k4 * 4) = make_float4(best[k4 * 4] * rden, best[k4 * 4 + 1] * rden, best[k4 * 4 + 2] * rden, best[k4 * 4 + 3] * rden);
    }
  }
}
DI float gelu_(float x) { return 0.5f * x * (1.f + erff(x * 0.70710678118654752f)); }
DI void fp8x16_to_f32(u32x4 v, float (&f)[16]) {
  const u32 w[4] = {v.x, v.y, v.z, v.w};
#pragma unroll
  for (int k = 0; k < 4; ++k) {
    f32x2 lo = __builtin_amdgcn_cvt_pk_f32_fp8((int)w[k], false), hi = __builtin_amdgcn_cvt_pk_f32_fp8((int)w[k], true);
    f[4 * k] = lo.x; f[4 * k + 1] = lo.y; f[4 * k + 2] = hi.x; f[4 * k + 3] = hi.y;
  }
}
DI void phase_gather(const Params& P) {
  char* ws = P.ws;
  const int* IDX = (const int*)(ws + OFF_IDX); const float* GATE = (const float*)(ws + OFF_GATE);
  const unsigned char* PU = (const unsigned char*)(ws + OFF_PU16); const unsigned char* PV = (const unsigned char*)(ws + OFF_PV16);
  u16* ACT = (u16*)(ws + OFF_ACT);
  const int lane = threadIdx.x & 63, wave = threadIdx.x >> 6;
  for (int t = blockIdx.x * 4 + wave; t < T_; t += gridDim.x * 4) {
    const u16* xr = ACT + (size_t)t * 1024 + lane * 16;
    float xf[16];
    {
      const u32x4 x0 = *(const u32x4*)xr, x1 = *(const u32x4*)(xr + 8);
      xf[0] = bflo(x0.x); xf[1] = bfhi(x0.x); xf[2] = bflo(x0.y); xf[3] = bfhi(x0.y); xf[4] = bflo(x0.z); xf[5] = bfhi(x0.z); xf[6] = bflo(x0.w); xf[7] = bfhi(x0.w);
      xf[8] = bflo(x1.x); xf[9] = bfhi(x1.x); xf[10] = bflo(x1.y); xf[11] = bfhi(x1.y); xf[12] = bflo(x1.z); xf[13] = bfhi(x1.z); xf[14] = bflo(x1.w); xf[15] = bfhi(x1.w);
    }
    int id[2]; float gt[2];
    id[0] = IDX[(size_t)t * 128 + lane]; id[1] = IDX[(size_t)t * 128 + 64 + lane];
    gt[0] = GATE[(size_t)t * 128 + lane]; gt[1] = GATE[(size_t)t * 128 + 64 + lane];
    float acc[16];
#pragma unroll
    for (int k = 0; k < 16; ++k) acc[k] = 0.f;
#pragma unroll
    for (int hf = 0; hf < 2; ++hf) {
#pragma unroll 1
      for (int hq = 0; hq < 4; ++hq) {
        u32x4 rec[16];
#pragma unroll
        for (int j = 0; j < 16; ++j) {
          const int row = __builtin_amdgcn_readlane(id[hf], hq * 16 + j);
          rec[j] = *(const u32x4*)(PU + (size_t)row * 1024 + lane * 16);
        }
        float dsel = 0.f;
        const int li = lane & 15;
#pragma unroll
        for (int j = 0; j < 16; ++j) {
          float uf[16]; fp4x8_to_f32(rec[j].x, uf); fp4x8_to_f32(rec[j].y, uf + 8);
          float p0 = 0.f, p1 = 0.f;
#pragma unroll
          for (int k = 0; k < 16; k += 2) { p0 = fmaf(uf[k], xf[k], p0); p1 = fmaf(uf[k + 1], xf[k + 1], p1); }
          float rs = sum8(p0 + p1); rs += dppf<0x140>(rs);
          dsel = (li == j) ? rs : dsel;
        }
        dsel += __shfl_xor(dsel, 16);
        dsel += __shfl_xor(dsel, 32);
        const float wsel = 0.1f * gt[hf] * gelu_(dsel * 0.015625f);
#pragma unroll
        for (int j = 0; j < 16; ++j) {
          const float w = rlf(wsel, hq * 16 + j);
          float vf[16]; fp4x8_to_f32(rec[j].z, vf); fp4x8_to_f32(rec[j].w, vf + 8);
#pragma unroll
          for (int k = 0; k < 16; ++k) acc[k] = fmaf(w, vf[k], acc[k]);
        }
      }
    }
    float* hr = P.out + (size_t)t * 1024 + lane * 16;
    float ss = 0.f;
#pragma unroll
    for (int q = 0; q < 4; ++q) {
      float4 hv = *(const float4*)(hr + 4 * q);
      hv.x += acc[4 * q]; hv.y += acc[4 * q + 1]; hv.z += acc[4 * q + 2]; hv.w += acc[4 * q + 3];
      *(float4*)(hr + 4 * q) = hv;
      acc[4 * q] = hv.x; acc[4 * q + 1] = hv.y; acc[4 * q + 2] = hv.z; acc[4 * q + 3] = hv.w;
      ss += hv.x * hv.x + hv.y * hv.y + hv.z * hv.z + hv.w * hv.w;
    }
    ss = wave_sum(ss);
    const float rs = rsqrtf(ss * (1.f / 1024.f) + 1e-6f);
    const float* g = P.norm_ple_g + lane * 16;
    u32 o[8];
#pragma unroll
    for (int q = 0; q < 4; ++q) {
      float4 gg = *(const float4*)(g + 4 * q);
      o[2 * q] = pack2(acc[4 * q] * rs * gg.x, acc[4 * q + 1] * rs * gg.y); o[2 * q + 1] = pack2(acc[4 * q + 2] * rs * gg.z, acc[4 * q + 3] * rs * gg.w);
    }
    u32x4 o0 = {o[0], o[1], o[2], o[3]}, o1 = {o[4], o[5], o[6], o[7]};
    *(u32x4*)(ACT + (size_t)t * 1024 + lane * 16) = o0; *(u32x4*)(ACT + (size_t)t * 1024 + lane * 16 + 8) = o1;
  }
}
DI void phase_ple(const Params& P, char* smem) {
  u16* sW = (u16*)smem; u16* sX = sW + 128 * LDS_LD;
  char* ws = P.ws;
  const u16* WgT = (const u16*)(ws + OFF_WGT); const u16* WpT = (const u16*)(ws + OFF_WPT);
  const u16* A = (const u16*)(ws + OFF_ACT); const u16* P16 = (const u16*)(ws + OFF_P16);
  const int lane = threadIdx.x & 63, wave = threadIdx.x >> 6, wn = wave >> 1, wm = wave & 1, r = lane & 31, h = lane >> 5;
  constexpr int NT = 8, MT = 256;
  for (int tile = blockIdx.x; tile < NT * MT; tile += gridDim.x) {
    int mt = tile / NT, nt = tile % NT;
    f32x16 acc[2][2], acc2[2][2]; zero_acc(acc); zero_acc(acc2);
    gemm_tile(acc, WgT + (size_t)nt * 128 * 1024, 1024, A + (size_t)mt * 128 * 1024, 1024, 1024, sW, sX);
    gemm_tile(acc2, WpT + (size_t)nt * 128 * 256, 256, P16 + (size_t)mt * 128 * 256, 256, 256, sW, sX);
#pragma unroll
    for (int ai = 0; ai < 2; ++ai)
#pragma unroll
      for (int bi = 0; bi < 2; ++bi) {
        const int nb = nt * 128 + wn * 64 + ai * 32;
        const size_t m = mt * 128 + wm * 64 + bi * 32 + r;
#pragma unroll
        for (int q = 0; q < 4; ++q) {
          const int n = nb + 8 * q + 4 * h;
          float4 hv = *(const float4*)(P.out + m * 1024 + n);
          hv.x += sigmoidf_(acc[ai][bi][4 * q]) * acc2[ai][bi][4 * q];
          hv.y += sigmoidf_(acc[ai][bi][4 * q + 1]) * acc2[ai][bi][4 * q + 1];
          hv.z += sigmoidf_(acc[ai][bi][4 * q + 2]) * acc2[ai][bi][4 * q + 2];
          hv.w += sigmoidf_(acc[ai][bi][4 * q + 3]) * acc2[ai][bi][4 * q + 3];
          *(float4*)(P.out + m * 1024 + n) = hv;
        }
      }
  }
}
DI void phase_final(const Params& P) {
  const int lane = threadIdx.x & 63, wave = threadIdx.x >> 6;
  for (int t = blockIdx.x * 4 + wave; t < T_; t += gridDim.x * 4) {
    float4* row = (float4*)(P.out + (size_t)t * 1024);
    float4 v[4]; float ss = 0.f;
#pragma unroll
    for (int i = 0; i < 4; ++i) { v[i] = row[lane + 64 * i]; ss += v[i].x * v[i].x + v[i].y * v[i].y + v[i].z * v[i].z + v[i].w * v[i].w; }
    ss = wave_sum(ss);
    const float rs = rsqrtf(ss * (1.f / 1024.f) + 1e-6f);
#pragma unroll
    for (int i = 0; i < 4; ++i) {
      float4 g = ((const float4*)P.norm_final_g)[lane + 64 * i];
      row[lane + 64 * i] = make_float4(v[i].x * rs * g.x, v[i].y * rs * g.y, v[i].z * rs * g.z, v[i].w * rs * g.w);
    }
  }
}

#ifndef PH_MASK
#define PH_MASK 0xFFFFFFFFu
#endif
#define PH(n) if ((PH_MASK >> (n)) & 1u)
#define XB_TMO      128
#define XB_XCNT(j)  (256  + 64 * (j))
#define XB_XSUB(j)  (1280 + 64 * (j))
#define XB_XGEN(j)  (2304 + 64 * (j))
#define XB_TOP      3328
#define XB_TOPGEN   3392
#define XCD_BAR_WORDS 3456
#define XB_SPIN_CAP (1u << 18)
#define LAS __attribute__((address_space(3)))

__device__ __forceinline__ unsigned xb_ld(unsigned* p)              { return __hip_atomic_load(p, __ATOMIC_RELAXED, __HIP_MEMORY_SCOPE_AGENT); }
__device__ __forceinline__ unsigned xb_add(unsigned* p, unsigned v) { return __hip_atomic_fetch_add(p, v, __ATOMIC_RELAXED, __HIP_MEMORY_SCOPE_AGENT); }
__device__ __forceinline__ unsigned xb_xcc_id() { return (unsigned)__builtin_amdgcn_s_getreg((3 << 11) | 20) & 0xFu; }
#define XB_SPIN(cond, bar) do { unsigned _sp = 0; while (cond) { __builtin_amdgcn_s_sleep(1); \
    if ((++_sp & 255u) == 0u) { if (xb_ld(&(bar)[XB_TMO])) break; if (_sp > XB_SPIN_CAP) { atomicAdd(&(bar)[XB_TMO], 1u); break; } } } } while (0)

struct XcdBarrier {
    unsigned* bar; unsigned x;
    volatile LAS unsigned* st;
};

__device__ __forceinline__ XcdBarrier xcd_barrier_post(unsigned* bar, volatile LAS unsigned* st) {
    XcdBarrier b; b.bar = bar; b.x = xb_xcc_id(); b.st = st;
    if (threadIdx.x == 0) (void)xb_add(&bar[XB_XCNT(b.x)], 1u);
    return b;
}
__device__ __forceinline__ void xcd_barrier_complete(unsigned* bar, unsigned x, unsigned& nloc, unsigned& nx) {
    const unsigned G = gridDim.x * gridDim.y * gridDim.z;
    unsigned sum, cnt, mine, sp = 0u;
    for (;;) {
        sum = 0u; cnt = 0u; mine = 0u;
#pragma unroll
        for (unsigned j = 0; j < 16; ++j) { const unsigned c = xb_ld(&bar[XB_XCNT(j)]); sum += c; cnt += (c > 0u) ? 1u : 0u; mine = (j == x) ? c : mine; }
        if (sum == G) break;
        __builtin_amdgcn_s_sleep(1);
        if ((++sp & 255u) == 0u) { if (xb_ld(&bar[XB_TMO])) break; if (sp > XB_SPIN_CAP) { atomicAdd(&bar[XB_TMO], 1u); break; } }
    }
    nloc = mine > 0u ? mine : 1u; nx = cnt > 0u ? cnt : 1u;
}

__device__ __forceinline__ void xcd_barrier(const XcdBarrier& b) {
    asm volatile("s_waitcnt vmcnt(0)" ::: "memory");
    __syncthreads();
    if (threadIdx.x == 0) {
        unsigned* bar = b.bar;
        __builtin_amdgcn_s_waitcnt(0);
        unsigned nloc = b.st[0], nx = b.st[1];
        if (nloc == 0u) { xcd_barrier_complete(bar, b.x, nloc, nx); b.st[0] = nloc; b.st[1] = nx; }
        const unsigned old = xb_add(&bar[XB_XSUB(b.x)], 1u);
        const unsigned gen = old / nloc;
        if (old + 1u == (gen + 1u) * nloc) {
            __builtin_amdgcn_fence(__ATOMIC_RELEASE, "agent");
            asm volatile("s_waitcnt vmcnt(0)" ::: "memory");
            const unsigned og = xb_add(&bar[XB_TOP], 1u);
            const unsigned tg = og / nx;
            if (og + 1u == (tg + 1u) * nx) xb_add(&bar[XB_TOPGEN], 1u);
            else XB_SPIN(xb_ld(&bar[XB_TOPGEN]) == tg, bar);
            __builtin_amdgcn_fence(__ATOMIC_ACQUIRE, "agent");
            xb_add(&bar[XB_XGEN(b.x)], 1u);
            asm volatile("s_waitcnt vmcnt(0)" ::: "memory");
        } else {
            XB_SPIN(xb_ld(&bar[XB_XGEN(b.x)]) == gen, bar);
            __builtin_amdgcn_fence(__ATOMIC_ACQUIRE, "agent");
            asm volatile("s_waitcnt vmcnt(0)" ::: "memory");
        }
    }
    __syncthreads();
}

constexpr int SMEM_BYTES = 2 * 2 * 128 * LDS_LD * 2;

__global__ void __launch_bounds__(256, 2) mega(Params P) {
  __shared__ __attribute__((aligned(16))) char smem[SMEM_BYTES];
  cg::grid_group grid = cg::this_grid();
  __shared__ __attribute__((aligned(16))) unsigned xb_st[4];
  if (threadIdx.x < 4) xb_st[threadIdx.x] = 0u;
  __syncthreads();
  XcdBarrier xb = xcd_barrier_post((unsigned*)(P.ws + OFF_CTR + 4096), (volatile LAS unsigned*)xb_st);
#define RUN(n, ...) PH(n) { if (P.ph_lo <= (n) && (n) <= P.ph_hi) { __VA_ARGS__; } } if (P.ph_lo <= (n) && (n) < P.ph_hi) { if ((n) == 0) grid.sync(); else xcd_barrier(xb); }
  RUN(0, phase_prep(P, smem))
  RUN(1, phase_gemm1(P, smem))
  RUN(2, phase_attn(P, smem); phase_rwprep(P))
  RUN(4, phase_lora(P, smem))
  RUN(5, phase_scan1(P, smem))
  RUN(6, phase_scan2(P, smem))
  RUN(7, phase_scan3(P, smem))
  RUN(8, phase_outproj(P, smem); convert_flat(P.p, (u16*)(P.ws + OFF_P16), (size_t)T_ * 256);
         convert_uv_fp4(P.peer_u, P.peer_v, (unsigned char*)(P.ws + OFF_PU16), 64.f, 10.f))
  RUN(9, rmsnorm_rows(P.out, P.norm_ffn_g, (u16*)(P.ws + OFF_ACT)))
  RUN(10, phase_qproj(P, smem, 0))
  RUN(11, phase_scores(P, smem))
  RUN(12, phase_qproj(P, smem, 1); phase_topk(P, 0))
  RUN(14, phase_scores(P, smem))
  RUN(15, phase_topk(P, 1))
  RUN(16, phase_gather(P))
  RUN(17, phase_ple(P, smem))
  RUN(18, phase_final(P))
}

extern "C" void kernel_launch(void* const* d_in, const int* in_sizes, int n_in, void* d_out, int out_size, void* d_ws, size_t ws_size,
                              hipStream_t stream) {
  static int grid_blocks = 0;
  if (!grid_blocks) {
    int dev = 0, cus = 0, per_cu = 0;
    hipGetDevice(&dev);
    hipDeviceGetAttribute(&cus, hipDeviceAttributeMultiprocessorCount, dev);
    hipOccupancyMaxActiveBlocksPerMultiprocessor(&per_cu, mega, 256, 0);
    if (per_cu < 1) per_cu = 1;
    if (per_cu > 2) per_cu = 2;
    grid_blocks = cus * per_cu;
  }
  Params P{};
  const float* const* fi = (const float* const*)d_in;
  P.x = fi[0]; P.p = fi[1]; P.pos = (const int*)d_in[2];
  P.norm_mix_g = fi[3]; P.w_in = fi[4]; P.lam_q1 = fi[5]; P.lam_k1 = fi[6]; P.lam_q2 = fi[7]; P.lam_k2 = fi[8]; P.subln_g = fi[9];
  P.rw_mu = fi[10]; P.rw_w0 = fi[11]; P.rw_w_up = fi[12]; P.rw_a0 = fi[13]; P.rw_a_up = fi[14]; P.rw_g_up = fi[15];
  P.rw_k_k = fi[16]; P.rw_k_a = fi[17]; P.rw_r_k = fi[18]; P.rw_ln_g = fi[19]; P.rw_ln_b = fi[20];
  P.w_out = fi[21]; P.norm_ffn_g = fi[22]; P.peer_w_q = fi[23]; P.peer_sub_keys = fi[24]; P.peer_u = fi[25]; P.peer_v = fi[26];
  P.norm_ple_g = fi[27]; P.ple_gate_w = fi[28]; P.ple_proj_w = fi[29]; P.norm_final_g = fi[30];
  P.out = (float*)d_out; P.ws = (char*)d_ws;
  for (int i = 0; i < 8; ++i) P.inv_freq[i] = (float)pow(500000.0, -(double)i / 8.0);
  hipMemsetAsync((char*)d_ws + OFF_CTR, 0, 32768, stream);
#ifndef ONE_LAUNCH
  for (int ph = 0; ph < 19; ++ph) {
    P.ph_lo = ph; P.ph_hi = ph;
    hipLaunchKernelGGL(mega, dim3(grid_blocks), dim3(256), 0, stream, P);
  }
#else
  P.ph_lo = 0; P.ph_hi = 18;
  void* args[] = {&P};
  hipLaunchCooperativeKernel((void*)mega, dim3(grid_blocks), dim3(256), args, 0, stream);
#endif
}
```

```cpp
#include <hip/hip_runtime.h>
#include <hip/hip_cooperative_groups.h>
#include <stdint.h>
#include <math.h>
namespace cg = cooperative_groups;

#define DI __device__ __forceinline__
#define ONE_LAUNCH 1
typedef unsigned short u16;
typedef unsigned int u32;
typedef __attribute__((ext_vector_type(4))) unsigned u32x4;
typedef __attribute__((ext_vector_type(2))) unsigned u32x2;
typedef __attribute__((ext_vector_type(8))) short bf16x8;
typedef __attribute__((ext_vector_type(4))) short s16x4;
typedef __attribute__((ext_vector_type(16))) float f32x16;
typedef __attribute__((ext_vector_type(2))) float f32x2;
typedef __attribute__((ext_vector_type(4))) float f32x4;
typedef __attribute__((ext_vector_type(2))) __bf16 bf16x2;
typedef const float __attribute__((address_space(4)))* cfptr;

constexpr int T_ = 32768, S_ = 8192, TH_ = 16384;
constexpr int CH_L = 128;
constexpr int CH_C = S_ / CH_L;
constexpr int NPHASE = 17;

constexpr size_t MiB = 1u << 20;
constexpr size_t OFF_WINT = 0;
constexpr size_t OFF_WOUTT = 7 * MiB;
constexpr size_t OFF_WQT = 9 * MiB;
constexpr size_t OFF_WGT = 13 * MiB;
constexpr size_t OFF_WPT = 15 * MiB;
constexpr size_t OFF_WLT = 15 * MiB + 512 * 1024;
constexpr size_t OFF_SUBK = 16 * MiB + 512 * 1024;
constexpr size_t OFF_ROPE = 17 * MiB;
constexpr size_t OFF_CTR = 19 * MiB;
constexpr size_t OFF_ACT = 20 * MiB;
constexpr size_t OFF_QK = 84 * MiB;
constexpr size_t OFF_VT = 148 * MiB;
constexpr size_t OFF_ZRW = 180 * MiB;
constexpr size_t OFF_V = 292 * MiB;
constexpr size_t OFF_AL = 356 * MiB;
constexpr size_t OFF_DD = 420 * MiB;
constexpr size_t OFF_L16 = 388 * MiB;
constexpr size_t OFF_PM = 100 * MiB;
constexpr size_t OFF_HM = 132 * MiB;
constexpr size_t OFF_BE = 180 * MiB;
constexpr size_t OFF_G16 = 244 * MiB;
constexpr size_t OFF_Q16 = 84 * MiB;
constexpr size_t OFF_ST = 148 * MiB;
constexpr size_t OFF_IDX = 276 * MiB;
constexpr size_t OFF_GATE = 292 * MiB;
constexpr size_t OFF_PU16 = 308 * MiB;
constexpr size_t OFF_PV16 = 340 * MiB;
constexpr size_t OFF_P16 = 468 * MiB;

struct Params {
  const float *x, *p; const int* pos;
  const float *norm_mix_g, *w_in, *lam_q1, *lam_k1, *lam_q2, *lam_k2, *subln_g;
  const float *rw_mu, *rw_w0, *rw_w_up, *rw_a0, *rw_a_up, *rw_g_up, *rw_k_k, *rw_k_a, *rw_r_k, *rw_ln_g, *rw_ln_b;
  const float *w_out, *norm_ffn_g, *peer_w_q, *peer_sub_keys, *peer_u, *peer_v, *norm_ple_g, *ple_gate_w, *ple_proj_w, *norm_final_g;
  float* out; char* ws;
  float inv_freq[8];
  int ph_lo, ph_hi;
};

DI u32 pack2(float a, float b) { f32x2 v = {a, b}; bf16x2 r = __builtin_convertvector(v, bf16x2); return __builtin_bit_cast(u32, r); }
DI u16 f2bf(float a) { return (u16)(pack2(a, 0.f) & 0xffffu); }
DI float bflo(u32 v) { return __uint_as_float(v << 16); }
DI float bfhi(u32 v) { return __uint_as_float(v & 0xffff0000u); }
DI f32x16 mfma32(bf16x8 a, bf16x8 b, f32x16 c) { return __builtin_amdgcn_mfma_f32_32x32x16_bf16(a, b, c, 0, 0, 0); }
DI int crow(int i, int h) { return (i & 3) + 8 * (i >> 2) + 4 * h; }
template <int CTRL> DI float dppf(float x) { return __int_as_float(__builtin_amdgcn_update_dpp(0, __float_as_int(x), CTRL, 0xf, 0xf, false)); }
DI float sum8(float x) { x += dppf<0xB1>(x); x += dppf<0x4E>(x); x += dppf<0x141>(x); return x; }
DI float rlf(float x, int l) { return __int_as_float(__builtin_amdgcn_readlane(__float_as_int(x), l)); }
DI float wave_sum(float x) {
  x = sum8(x); x += dppf<0x140>(x);
  return (rlf(x, 0) + rlf(x, 16)) + (rlf(x, 32) + rlf(x, 48));
}
DI float xor32(float x) { return __shfl_xor(x, 32); }
DI cfptr to_const(const float* p) { return (cfptr)(uintptr_t)p; }
DI float sigmoidf_(float x) { return 1.f / (1.f + __expf(-x)); }
DI float dot8(u32x4 a, u32x4 b, float acc) {
  acc = fmaf(bflo(a.x), bflo(b.x), acc); acc = fmaf(bfhi(a.x), bfhi(b.x), acc);
  acc = fmaf(bflo(a.y), bflo(b.y), acc); acc = fmaf(bfhi(a.y), bfhi(b.y), acc);
  acc = fmaf(bflo(a.z), bflo(b.z), acc); acc = fmaf(bfhi(a.z), bfhi(b.z), acc);
  acc = fmaf(bflo(a.w), bflo(b.w), acc); acc = fmaf(bfhi(a.w), bfhi(b.w), acc);
  return acc;
}

constexpr int LDS_LD = 72;
constexpr int G_BUF = 2 * 128 * LDS_LD;
DI void gemm_tile(f32x16 (&acc)[2][2], const u16* Wt, int ldw, const u16* X, int ldx, int K, u16* sW, u16* sX) {
  const int tid = threadIdx.x, lane = tid & 63, wave = tid >> 6;
  const int wn = wave >> 1, wm = wave & 1, r = lane & 31, h = lane >> 5;
  const u16* gw = Wt + (size_t)(tid >> 3) * ldw + (tid & 7) * 8;
  const u16* gx = X + (size_t)(tid >> 3) * ldx + (tid & 7) * 8;
  u16* lw = sW + (tid >> 3) * LDS_LD + (tid & 7) * 8;
  u16* lx = sX + (tid >> 3) * LDS_LD + (tid & 7) * 8;
  const size_t sw32 = (size_t)32 * ldw, sx32 = (size_t)32 * ldx;
  const u16* pa = sW + (wn * 64 + r) * LDS_LD + h * 8;
  const u16* pb = sX + (wm * 64 + r) * LDS_LD + h * 8;
  const int nk = K >> 6;
  u32x4 r0w[4], r0x[4], r1w[4], r1x[4];
#define G_LOAD(RW, RX, kt) { _Pragma("unroll") for (int i = 0; i < 4; ++i) { RW[i] = *(const u32x4*)(gw + i * sw32 + (kt) * 64); RX[i] = *(const u32x4*)(gx + i * sx32 + (kt) * 64); } }
#define G_STORE(RW, RX, st) { _Pragma("unroll") for (int i = 0; i < 4; ++i) { *(u32x4*)(lw + (st) * G_BUF + i * 32 * LDS_LD) = RW[i]; *(u32x4*)(lx + (st) * G_BUF + i * 32 * LDS_LD) = RX[i]; } }
#define G_COMPUTE(st) { _Pragma("unroll") for (int ks = 0; ks < 4; ++ks) { bf16x8 a[2], b[2]; \
    _Pragma("unroll") for (int i = 0; i < 2; ++i) { a[i] = *(const bf16x8*)(pa + (st) * G_BUF + i * 32 * LDS_LD + ks * 16); b[i] = *(const bf16x8*)(pb + (st) * G_BUF + i * 32 * LDS_LD + ks * 16); } \
    _Pragma("unroll") for (int i = 0; i < 2; ++i) _Pragma("unroll") for (int jj = 0; jj < 2; ++jj) acc[i][jj] = mfma32(a[i], b[jj], acc[i][jj]); } }
  G_LOAD(r0w, r0x, 0)
  __syncthreads();
  G_STORE(r0w, r0x, 0)
  G_LOAD(r0w, r0x, 1)
  if (nk > 2) G_LOAD(r1w, r1x, 2)
  __syncthreads();
  for (int k = 0; k < nk; k += 2) {
    __builtin_amdgcn_s_setprio(3); G_COMPUTE(0) __builtin_amdgcn_s_setprio(0);
    G_STORE(r0w, r0x, 1)
    if (k + 3 < nk) G_LOAD(r0w, r0x, k + 3)
    __syncthreads();
    __builtin_amdgcn_s_setprio(3); G_COMPUTE(1) __builtin_amdgcn_s_setprio(0);
    if (k + 2 < nk) {
      G_STORE(r1w, r1x, 0)
      if (k + 4 < nk) G_LOAD(r1w, r1x, k + 4)
      __syncthreads();
    }
  }
#undef G_LOAD
#undef G_STORE
#undef G_COMPUTE
}
DI void zero_acc(f32x16 (&acc)[2][2]) {
#pragma unroll
  for (int i = 0; i < 2; ++i)
#pragma unroll
    for (int j = 0; j < 2; ++j)
#pragma unroll
      for (int k = 0; k < 16; ++k) acc[i][j][k] = 0.f;
}

DI void transpose_tile(const float* src, int N, int kt, int nt, u16* dst, int ldd, int kofs, bool valid, float* tile) {
  const int tid = threadIdx.x;
  if (valid) {
#pragma unroll 4
    for (int i = 0; i < 16; ++i) {
      int idx = tid + 256 * i, kk = idx >> 6, nn = idx & 63;
      tile[kk * 65 + nn] = src[(size_t)(kt * 64 + kk) * N + nt * 64 + nn];
    }
  }
  __syncthreads();
#pragma unroll 4
  for (int i = 0; i < 16; ++i) {
    int idx = tid + 256 * i, nn = idx >> 6, kk = idx & 63;
    float v = valid ? tile[kk * 65 + nn] : 0.f;
    dst[(size_t)(nt * 64 + nn) * ldd + kofs + kt * 64 + kk] = f2bf(v);
  }
  __syncthreads();
}
DI void transpose_all(const float* src, int K, int N, u16* dst, float* tile) {
  int KT = K / 64, NTt = N / 64;
  for (int t = blockIdx.x; t < KT * NTt; t += gridDim.x) transpose_tile(src, N, t % KT, t / KT, dst, K, 0, true, tile);
}
DI void convert_flat(const float* src, u16* dst, size_t n) {
  size_t n4 = n / 4;
  for (size_t i = (size_t)blockIdx.x * 256 + threadIdx.x; i < n4; i += (size_t)gridDim.x * 256) {
    float4 v = ((const float4*)src)[i];
    u32x2 o = {pack2(v.x, v.y), pack2(v.z, v.w)};
    ((u32x2*)dst)[i] = o;
  }
}
DI void convert_fp8(const float* src, unsigned char* dst, size_t n, float scale) {
  size_t n8 = n / 8;
  for (size_t i = (size_t)blockIdx.x * 256 + threadIdx.x; i < n8; i += (size_t)gridDim.x * 256) {
    float4 a = ((const float4*)src)[2 * i], b = ((const float4*)src)[2 * i + 1];
    int r0 = __builtin_amdgcn_cvt_pk_fp8_f32(a.x * scale, a.y * scale, 0, false);
    r0 = __builtin_amdgcn_cvt_pk_fp8_f32(a.z * scale, a.w * scale, r0, true);
    int r1 = __builtin_amdgcn_cvt_pk_fp8_f32(b.x * scale, b.y * scale, 0, false);
    r1 = __builtin_amdgcn_cvt_pk_fp8_f32(b.z * scale, b.w * scale, r1, true);
    u32x2 o = {(u32)r0, (u32)r1};
    ((u32x2*)dst)[i] = o;
  }
}
DI void convert_fp4(const float* src, unsigned char* dst, size_t n, float scale) {
  size_t n8 = n / 8;
  for (size_t i = (size_t)blockIdx.x * 256 + threadIdx.x; i < n8; i += (size_t)gridDim.x * 256) {
    float4 a = ((const float4*)src)[2 * i], b = ((const float4*)src)[2 * i + 1];
    u32 r = 0u;
    r = __builtin_amdgcn_cvt_scalef32_pk_fp4_f32(r, a.x * scale, a.y * scale, 1.0f, 0);
    r = __builtin_amdgcn_cvt_scalef32_pk_fp4_f32(r, a.z * scale, a.w * scale, 1.0f, 1);
    r = __builtin_amdgcn_cvt_scalef32_pk_fp4_f32(r, b.x * scale, b.y * scale, 1.0f, 2);
    r = __builtin_amdgcn_cvt_scalef32_pk_fp4_f32(r, b.z * scale, b.w * scale, 1.0f, 3);
    ((u32*)dst)[i] = r;
  }
}
DI void fp4x8_to_f32(u32 w, float* f) {
  f32x2 p0 = __builtin_amdgcn_cvt_scalef32_pk_f32_fp4(w, 1.0f, 0), p1 = __builtin_amdgcn_cvt_scalef32_pk_f32_fp4(w, 1.0f, 1);
  f32x2 p2 = __builtin_amdgcn_cvt_scalef32_pk_f32_fp4(w, 1.0f, 2), p3 = __builtin_amdgcn_cvt_scalef32_pk_f32_fp4(w, 1.0f, 3);
  f[0] = p0.x; f[1] = p0.y; f[2] = p1.x; f[3] = p1.y; f[4] = p2.x; f[5] = p2.y; f[6] = p3.x; f[7] = p3.y;
}
DI u32 pack_fp4x8(const float4 a, const float4 b, float scale) {
  u32 r = 0u;
  r = __builtin_amdgcn_cvt_scalef32_pk_fp4_f32(r, a.x * scale, a.y * scale, 1.0f, 0);
  r = __builtin_amdgcn_cvt_scalef32_pk_fp4_f32(r, a.z * scale, a.w * scale, 1.0f, 1);
  r = __builtin_amdgcn_cvt_scalef32_pk_fp4_f32(r, b.x * scale, b.y * scale, 1.0f, 2);
  r = __builtin_amdgcn_cvt_scalef32_pk_fp4_f32(r, b.z * scale, b.w * scale, 1.0f, 3);
  return r;
}
DI void convert_uv_fp4(const float* u, const float* v, unsigned char* dst, float su, float sv) {
  const size_t n = (size_t)16384 * 64;
  for (size_t i = (size_t)blockIdx.x * 256 + threadIdx.x; i < n; i += (size_t)gridDim.x * 256) {
    const float4* pu = (const float4*)(u + i * 16); const float4* pv = (const float4*)(v + i * 16);
    u32x4 o = {pack_fp4x8(pu[0], pu[1], su), pack_fp4x8(pu[2], pu[3], su), pack_fp4x8(pv[0], pv[1], sv), pack_fp4x8(pv[2], pv[3], sv)};
    ((u32x4*)dst)[i] = o;
  }
}
DI void rmsnorm_rows(const float* src, const float* g, u16* dst) {
  const int lane = threadIdx.x & 63, wave = threadIdx.x >> 6;
  for (int t = blockIdx.x * 4 + wave; t < T_; t += gridDim.x * 4) {
    const float4* row = (const float4*)(src + (size_t)t * 1024);
    float4 v[4]; float ss = 0.f;
#pragma unroll
    for (int i = 0; i < 4; ++i) { v[i] = row[lane + 64 * i]; ss += v[i].x * v[i].x + v[i].y * v[i].y + v[i].z * v[i].z + v[i].w * v[i].w; }
    ss = wave_sum(ss);
    float rs = rsqrtf(ss * (1.f / 1024.f) + 1e-6f);
#pragma unroll
    for (int i = 0; i < 4; ++i) {
      float4 gg = ((const float4*)g)[lane + 64 * i];
      u32x2 o = {pack2(v[i].x * rs * gg.x, v[i].y * rs * gg.y), pack2(v[i].z * rs * gg.z, v[i].w * rs * gg.w)};
      ((u32x2*)(dst + (size_t)t * 1024))[lane + 64 * i] = o;
    }
  }
}
DI void phase_prep(const Params& P, char* smem) {
  float* tile = (float*)smem;
  char* ws = P.ws;
  transpose_all(P.w_in, 1024, 3328, (u16*)(ws + OFF_WINT), tile);
  transpose_all(P.w_out, 1024, 1024, (u16*)(ws + OFF_WOUTT), tile);
  transpose_all(P.peer_w_q, 1024, 2048, (u16*)(ws + OFF_WQT), tile);
  transpose_all(P.ple_gate_w, 1024, 1024, (u16*)(ws + OFF_WGT), tile);
  transpose_all(P.ple_proj_w, 256, 1024, (u16*)(ws + OFF_WPT), tile);
  for (int t = blockIdx.x; t < 24 * 4; t += gridDim.x) {
    int nt = t >> 2, kt = t & 3, sec = nt >> 3, ntl = nt & 7;
    const float* src; int kts; bool valid;
    if (sec == 0) { src = P.rw_w_up; valid = (kt == 0); kts = 0; }
    else if (sec == 1) { src = P.rw_a_up; valid = (kt == 1); kts = 0; }
    else { src = P.rw_g_up; valid = (kt >= 2); kts = kt - 2; }
    transpose_tile(src, 512, kts, ntl, (u16*)(ws + OFF_WLT) + (size_t)sec * 512 * 256, 256, (kt - kts) * 64, valid, tile);
  }
  convert_flat(P.peer_sub_keys, (u16*)(ws + OFF_SUBK), (size_t)16 * 128 * 128);
  float2* rope = (float2*)(ws + OFF_ROPE);
  for (int i = blockIdx.x * 256 + threadIdx.x; i < T_ * 8; i += gridDim.x * 256) {
    int m = i >> 3, f = i & 7;
    float ang = (float)P.pos[m] * P.inv_freq[f];
    double a = (double)ang;
    double k = rint(a * 0.15915494309189535);
    float rr = (float)(a - k * 6.283185307179586);
    rope[i] = make_float2(__cosf(rr), __sinf(rr));
  }
  rmsnorm_rows(P.x, P.norm_mix_g, (u16*)(ws + OFF_ACT));
}

DI void phase_gemm1(const Params& P, char* smem) {
  u16* sW = (u16*)smem; u16* sX = sW + 128 * LDS_LD;
  char* ws = P.ws;
  const u16* WinT = (const u16*)(ws + OFF_WINT); const u16* ACT = (const u16*)(ws + OFF_ACT);
  const float2* rope = (const float2*)(ws + OFF_ROPE);
  u16* QK = (u16*)(ws + OFF_QK); u16* VT = (u16*)(ws + OFF_VT); u16* ZRW = (u16*)(ws + OFF_ZRW);
  const int lane = threadIdx.x & 63, wave = threadIdx.x >> 6, wn = wave >> 1, wm = wave & 1, r = lane & 31, h = lane >> 5;
  constexpr int NT = 26, MT = 256;
  for (int tile = blockIdx.x; tile < NT * MT; tile += gridDim.x) {
    int mt = tile / NT, nt = tile % NT;
    f32x16 acc[2][2]; zero_acc(acc);
    gemm_tile(acc, WinT + (size_t)nt * 128 * 1024, 1024, ACT + (size_t)mt * 128 * 1024, 1024, 1024, sW, sX);
#pragma unroll
    for (int ai = 0; ai < 2; ++ai)
#pragma unroll
      for (int bi = 0; bi < 2; ++bi) {
        const int nb = nt * 128 + wn * 64 + ai * 32;
        const int m = mt * 128 + wm * 64 + bi * 32 + r;
        f32x16 v = acc[ai][bi];
        if (nb < 1024) {
          if ((nb & 63) == 0) {
#pragma unroll
            for (int i = 0; i < 4; ++i) {
              float2 cs = rope[m * 8 + 4 * h + i];
              float t1 = v[i], t2 = v[i + 4];
              v[i] = t1 * cs.x - t2 * cs.y; v[i + 4] = t2 * cs.x + t1 * cs.y;
            }
          }
          if (nb < 512) {
#pragma unroll
            for (int i = 0; i < 16; ++i) v[i] *= 0.125f;
          }
#pragma unroll
          for (int q = 0; q < 4; ++q) {
            u32x2 pk = {pack2(v[4 * q], v[4 * q + 1]), pack2(v[4 * q + 2], v[4 * q + 3])};
            *(u32x2*)(QK + (size_t)m * 1024 + nb + 8 * q + 4 * h) = pk;
          }
        } else if (nb < 1536) {
          const int hh = (nb - 1024) >> 7, dv0 = (nb - 1024) & 127, b = m >> 13, s = m & 8191;
#pragma unroll
          for (int i = 0; i < 16; ++i) VT[((size_t)((b * 4 + hh) * 128 + dv0 + crow(i, h))) * S_ + s] = f2bf(v[i]);
        } else {
#pragma unroll
          for (int q = 0; q < 4; ++q) {
            u32x2 pk = {pack2(v[4 * q], v[4 * q + 1]), pack2(v[4 * q + 2], v[4 * q + 3])};
            *(u32x2*)(ZRW + (size_t)m * 1792 + (nb - 1536) + 8 * q + 4 * h) = pk;
          }
        }
      }
  }
}

DI void phase_attn(const Params& P, char* smem) {
  constexpr int ATT_BUF = (64 + 128) * LDS_LD;
  u16* sK = (u16*)smem;
  u16* sV = sK + 64 * LDS_LD;
  int* sItem = (int*)(sK + 2 * ATT_BUF);
  char* ws = P.ws;
  const u16* QK = (const u16*)(ws + OFF_QK); const u16* VT = (const u16*)(ws + OFF_VT);
  u16* CAT = (u16*)(ws + OFF_ACT);
  unsigned* ctr = (unsigned*)(ws + OFF_CTR);
  const int tid = threadIdx.x, lane = tid & 63, wave = tid >> 6, r = lane & 31, h = lane >> 5;
  float d1 = 0.f, d2 = 0.f;
  for (int i = 0; i < 64; ++i) { d1 += P.lam_q1[i] * P.lam_k1[i]; d2 += P.lam_q2[i] * P.lam_k2[i]; }
  const float lam = expf(d1) - expf(d2) + 0.2f;
  const float LOG2E = 1.4426950408889634f;
  for (;;) {
    __syncthreads();
    if (tid == 0) *sItem = (int)atomicAdd(ctr, 1u);
    __syncthreads();
    const int item = *sItem;
    if (item >= 1024) break;
    const int qt = 63 - (item >> 4), bh = item & 15, b = bh >> 2, hh = bh & 3;
    const int qlo = qt * 128 + wave * 32;
    const size_t mq = (size_t)b * S_ + qlo + r;
    const int ntiles = 2 * qt + 2;
    float4* scr = (float4*)(ws + 324 * MiB) + (size_t)blockIdx.x * 16 * 256 + tid;
#pragma unroll
    for (int c = 0; c < 2; ++c) {
      bf16x8 qf[4];
#pragma unroll
      for (int ks = 0; ks < 4; ++ks) qf[ks] = *(const bf16x8*)(QK + mq * 1024 + hh * 128 + c * 64 + ks * 16 + h * 8);
      f32x16 o[4];
#pragma unroll
      for (int d = 0; d < 4; ++d)
#pragma unroll
        for (int i = 0; i < 16; ++i) o[d][i] = 0.f;
      float mrow = -1e30f, lsum = 0.f;
      const u16* kbase = QK + ((size_t)b * S_) * 1024 + 512 + hh * 128 + c * 64;
      const u16* vbase = VT + ((size_t)(b * 4 + hh) * 128) * S_;
      u32x4 rk[2], rv[4];
#pragma unroll
      for (int i = 0; i < 2; ++i) { int cc = tid + 256 * i, row = cc >> 3, kc = cc & 7; rk[i] = *(const u32x4*)(kbase + (size_t)row * 1024 + kc * 8); }
#pragma unroll
      for (int i = 0; i < 4; ++i) { int cc = tid + 256 * i, row = cc >> 3, kc = cc & 7; rv[i] = *(const u32x4*)(vbase + (size_t)row * S_ + kc * 8); }
      __syncthreads();
#pragma unroll
      for (int i = 0; i < 2; ++i) { int cc = tid + 256 * i, row = cc >> 3, kc = cc & 7; *(u32x4*)(sK + row * LDS_LD + kc * 8) = rk[i]; }
#pragma unroll
      for (int i = 0; i < 4; ++i) { int cc = tid + 256 * i, row = cc >> 3, kc = cc & 7; *(u32x4*)(sV + row * LDS_LD + kc * 8) = rv[i]; }
      __syncthreads();
      for (int j = 0; j < ntiles; ++j) {
        const int cur = j & 1;
        const u16* sKc = sK + cur * ATT_BUF; const u16* sVc = sV + cur * ATT_BUF;
        u16* sKn = sK + (cur ^ 1) * ATT_BUF; u16* sVn = sV + (cur ^ 1) * ATT_BUF;
        const bool more = (j + 1 < ntiles);
        if (more) {
          const int k0 = (j + 1) * 64;
#pragma unroll
          for (int i = 0; i < 2; ++i) { int cc = tid + 256 * i, row = cc >> 3, kc = cc & 7; rk[i] = *(const u32x4*)(kbase + (size_t)(k0 + row) * 1024 + kc * 8); }
#pragma unroll
          for (int i = 0; i < 4; ++i) { int cc = tid + 256 * i, row = cc >> 3, kc = cc & 7; rv[i] = *(const u32x4*)(vbase + (size_t)row * S_ + k0 + kc * 8); }
        }
        f32x16 st[2];
        float mnew = 0.f;
        const int key0 = j * 64;
        if (key0 <= qlo + 31) {
          __builtin_amdgcn_s_setprio(3);
#pragma unroll
          for (int kb = 0; kb < 2; ++kb) {
#pragma unroll
            for (int i = 0; i < 16; ++i) st[kb][i] = 0.f;
#pragma unroll
            for (int ks = 0; ks < 4; ++ks) {
              bf16x8 kf = *(const bf16x8*)(sKc + (kb * 32 + r) * LDS_LD + ks * 16 + h * 8);
              st[kb] = mfma32(kf, qf[ks], st[kb]);
            }
          }
          __builtin_amdgcn_s_setprio(0);
          const bool need_mask = (key0 + 63 > qlo);
          float mx = -1e30f;
#pragma unroll
          for (int kb = 0; kb < 2; ++kb)
#pragma unroll
            for (int i = 0; i < 16; ++i) {
              float s = st[kb][i] * LOG2E;
              if (need_mask) { int key = key0 + kb * 32 + crow(i, h); if (key > qlo + r) s = -1e30f; }
              st[kb][i] = s; mx = fmaxf(mx, s);
            }
          mx = fmaxf(mx, xor32(mx));
          mnew = fmaxf(mrow, mx);
          const float alpha = __builtin_amdgcn_exp2f(mrow - mnew);
          mrow = mnew;
          float ps = 0.f;
#pragma unroll
          for (int kb = 0; kb < 2; ++kb)
#pragma unroll
            for (int i = 0; i < 16; ++i) { float p = __builtin_amdgcn_exp2f(st[kb][i] - mnew); st[kb][i] = p; ps += p; }
          lsum = lsum * alpha + ps;
#pragma unroll
          for (int d = 0; d < 4; ++d)
#pragma unroll
            for (int i = 0; i < 16; ++i) o[d][i] *= alpha;
        }
        if (more) {
#pragma unroll
          for (int i = 0; i < 2; ++i) { int cc = tid + 256 * i, row = cc >> 3, kc = cc & 7; *(u32x4*)(sKn + row * LDS_LD + kc * 8) = rk[i]; }
#pragma unroll
          for (int i = 0; i < 4; ++i) { int cc = tid + 256 * i, row = cc >> 3, kc = cc & 7; *(u32x4*)(sVn + row * LDS_LD + kc * 8) = rv[i]; }
        }
        if (key0 <= qlo + 31) {
          __builtin_amdgcn_s_setprio(3);
#pragma unroll
          for (int kb = 0; kb < 2; ++kb)
#pragma unroll
            for (int s = 0; s < 2; ++s) {
              u32x4 pp = {pack2(st[kb][8 * s], st[kb][8 * s + 1]), pack2(st[kb][8 * s + 2], st[kb][8 * s + 3]),
                          pack2(st[kb][8 * s + 4], st[kb][8 * s + 5]), pack2(st[kb][8 * s + 6], st[kb][8 * s + 7])};
              bf16x8 pf = __builtin_bit_cast(bf16x8, pp);
#pragma unroll
              for (int d = 0; d < 4; ++d) {
                const u16* vp = sVc + (d * 32 + r) * LDS_LD + kb * 32 + 16 * s + 4 * h;
                s16x4 lo = *(const s16x4*)vp, hi = *(const s16x4*)(vp + 8);
                bf16x8 vf = __builtin_shufflevector(lo, hi, 0, 1, 2, 3, 4, 5, 6, 7);
                o[d] = mfma32(vf, pf, o[d]);
              }
            }
          __builtin_amdgcn_s_setprio(0);
        }
        __syncthreads();
      }
      const float ltot = lsum + xor32(lsum);
      const float inv = 1.f / ltot;
      if (c == 0) {
#pragma unroll
        for (int d = 0; d < 4; ++d)
#pragma unroll
          for (int q = 0; q < 4; ++q) scr[(d * 4 + q) * 256] = make_float4(o[d][4 * q] * inv, o[d][4 * q + 1] * inv, o[d][4 * q + 2] * inv, o[d][4 * q + 3] * inv);
      } else {
        float ss = 0.f;
        const float li = lam * inv;
#pragma unroll
        for (int d = 0; d < 4; ++d)
#pragma unroll
          for (int q = 0; q < 4; ++q) {
            float4 p0 = scr[(d * 4 + q) * 256];
            float v0 = p0.x - li * o[d][4 * q], v1 = p0.y - li * o[d][4 * q + 1], v2 = p0.z - li * o[d][4 * q + 2], v3 = p0.w - li * o[d][4 * q + 3];
            o[d][4 * q] = v0; o[d][4 * q + 1] = v1; o[d][4 * q + 2] = v2; o[d][4 * q + 3] = v3;
            ss += v0 * v0 + v1 * v1 + v2 * v2 + v3 * v3;
          }
        ss += xor32(ss);
        const float rs = rsqrtf(ss * (1.f / 128.f) + 1e-6f) * 0.8f;
#pragma unroll
        for (int d = 0; d < 4; ++d)
#pragma unroll
          for (int q = 0; q < 4; ++q) {
            const int dv = d * 32 + 8 * q + 4 * h;
            float4 g = *(const float4*)(P.subln_g + dv);
            u32x2 pk = {pack2(o[d][4 * q] * rs * g.x, o[d][4 * q + 1] * rs * g.y), pack2(o[d][4 * q + 2] * rs * g.z, o[d][4 * q + 3] * rs * g.w)};
            *(u32x2*)(CAT + mq * 1024 + hh * 128 + dv) = pk;
          }
      }
    }
  }
}

DI void load8(const u16* p, float (&f)[8]) {
  u32x4 v = *(const u32x4*)p;
  f[0] = bflo(v.x); f[1] = bfhi(v.x); f[2] = bflo(v.y); f[3] = bfhi(v.y); f[4] = bflo(v.z); f[5] = bfhi(v.z); f[6] = bflo(v.w); f[7] = bfhi(v.w);
}
DI void shift8(const u16* zc, bool first, const float* mu, float (&z)[8]) {
  float c[8], p[8];
  load8(zc, c);
  if (first) { for (int e = 0; e < 8; ++e) p[e] = 0.f; } else load8(zc - 1792, p);
  float4 m0 = *(const float4*)mu, m1 = *(const float4*)(mu + 4);
  float mm[8] = {m0.x, m0.y, m0.z, m0.w, m1.x, m1.y, m1.z, m1.w};
#pragma unroll
  for (int e = 0; e < 8; ++e) z[e] = c[e] + (p[e] - c[e]) * mm[e];
}
DI void store8h(u16* dst, const float (&z)[8]) {
  u32x4 o = {pack2(z[0], z[1]), pack2(z[2], z[3]), pack2(z[4], z[5]), pack2(z[6], z[7])};
  *(u32x4*)dst = o;
}
DI void store8f(float* dst, const float (&z)[8]) {
  *(float4*)dst = make_float4(z[0], z[1], z[2], z[3]); *(float4*)(dst + 4) = make_float4(z[4], z[5], z[6], z[7]);
}
DI void phase_rwprep(const Params& P) {
  char* ws = P.ws;
  const u16* ZRW = (const u16*)(ws + OFF_ZRW);
  u16* Rb = (u16*)P.out; u16* Kb = (u16*)P.out + (size_t)T_ * 512;
  u16* Vb = (u16*)(ws + OFF_V); u16* ALb = (u16*)(ws + OFF_AL); u16* L16 = (u16*)(ws + OFF_L16);
  const int lane = threadIdx.x & 63, wave = threadIdx.x >> 6;
  for (int t = blockIdx.x * 4 + wave; t < T_; t += gridDim.x * 4) {
    const bool first = (t & (S_ - 1)) == 0;
    const u16* zc = ZRW + (size_t)t * 1792;
    float z[8];
    shift8(zc + lane * 8, first, P.rw_mu + lane * 8, z);
    store8h(Rb + (size_t)t * 512 + lane * 8, z);
    shift8(zc + 512 + lane * 8, first, P.rw_mu + 512 + lane * 8, z);
    store8h(Kb + (size_t)t * 512 + lane * 8, z);
    {
      float4 k0 = *(const float4*)(P.rw_k_k + lane * 8), k1 = *(const float4*)(P.rw_k_k + lane * 8 + 4);
      float kk[8] = {z[0] * k0.x, z[1] * k0.y, z[2] * k0.z, z[3] * k0.w, z[4] * k1.x, z[5] * k1.y, z[6] * k1.z, z[7] * k1.w};
      float ss = 0.f;
#pragma unroll
      for (int e = 0; e < 8; ++e) ss += kk[e] * kk[e];
      ss = sum8(ss);
      float inv = -1.f / fmaxf(sqrtf(ss), 1e-12f);
#pragma unroll
      for (int e = 0; e < 8; ++e) kk[e] *= inv;
      store8h(ALb + (size_t)t * 512 + lane * 8, kk);
    }
    shift8(zc + 1024 + lane * 8, first, P.rw_mu + 1024 + lane * 8, z);
    store8h(Vb + (size_t)t * 512 + lane * 8, z);
    if (lane < 32) {
      shift8(zc + 1536 + lane * 8, first, P.rw_mu + 1536 + lane * 8, z);
      if (lane < 8) { for (int e = 0; e < 8; ++e) z[e] = tanhf(z[e]); }
      else if (lane >= 16) { for (int e = 0; e < 8; ++e) z[e] = sigmoidf_(z[e]); }
      u32x4 o = {pack2(z[0], z[1]), pack2(z[2], z[3]), pack2(z[4], z[5]), pack2(z[6], z[7])};
      *(u32x4*)(L16 + (size_t)t * 256 + lane * 8) = o;
    }
  }
}

DI void phase_lora(const Params& P, char* smem) {
  u16* sW = (u16*)smem; u16* sX = sW + 128 * LDS_LD;
  char* ws = P.ws;
  const u16* WlT = (const u16*)(ws + OFF_WLT); const u16* L16 = (const u16*)(ws + OFF_L16);
  u16* Kb = (u16*)P.out + (size_t)T_ * 512; const u16* ALb = (const u16*)(ws + OFF_AL);
  u16* BEb = (u16*)(ws + OFF_BE); float* DDb = (float*)(ws + OFF_DD); u16* G16 = (u16*)(ws + OFF_G16);
  const int lane = threadIdx.x & 63, wave = threadIdx.x >> 6, wn = wave >> 1, wm = wave & 1, r = lane & 31, h = lane >> 5;
  constexpr int NT = 12, MT = 256;
  for (int tile = blockIdx.x; tile < NT * MT; tile += gridDim.x) {
    int mt = tile / NT, nt = tile % NT;
    f32x16 acc[2][2]; zero_acc(acc);
    gemm_tile(acc, WlT + (size_t)nt * 128 * 256, 256, L16 + (size_t)mt * 128 * 256, 256, 256, sW, sX);
#pragma unroll
    for (int ai = 0; ai < 2; ++ai)
#pragma unroll
      for (int bi = 0; bi < 2; ++bi) {
        const int nb = nt * 128 + wn * 64 + ai * 32;
        const size_t m = mt * 128 + wm * 64 + bi * 32 + r;
        const f32x16 v = acc[ai][bi];
#pragma unroll
        for (int q = 0; q < 4; ++q) {
          const int ch = (nb & 511) + 8 * q + 4 * h;
          float a4[4] = {v[4 * q], v[4 * q + 1], v[4 * q + 2], v[4 * q + 3]};
          if (nb < 512) {
            float4 w0 = *(const float4*)(P.rw_w0 + ch);
            float ww[4] = {w0.x, w0.y, w0.z, w0.w}, dd[4];
#pragma unroll
            for (int e = 0; e < 4; ++e) {
              float xx = -(ww[e] + a4[e]);
              float sp = fmaxf(xx, 0.f) + log1pf(__expf(-fabsf(xx)));
              float w = -sp - 0.5f;
              dd[e] = __expf(-__expf(w));
            }
            *(float4*)(DDb + m * 512 + ch) = make_float4(dd[0], dd[1], dd[2], dd[3]);
          } else if (nb < 1024) {
            float4 a0 = *(const float4*)(P.rw_a0 + ch), ka = *(const float4*)(P.rw_k_a + ch);
            const u32x2 kvp = *(const u32x2*)(Kb + m * 512 + ch), alp = *(const u32x2*)(ALb + m * 512 + ch);
            const float kv[4] = {bflo(kvp.x), bfhi(kvp.x), bflo(kvp.y), bfhi(kvp.y)}, al[4] = {bflo(alp.x), bfhi(alp.x), bflo(alp.y), bfhi(alp.y)};
            float aa[4] = {sigmoidf_(a0.x + a4[0]), sigmoidf_(a0.y + a4[1]), sigmoidf_(a0.z + a4[2]), sigmoidf_(a0.w + a4[3])};
            u32x2 bo = {pack2(-al[0] * aa[0], -al[1] * aa[1]), pack2(-al[2] * aa[2], -al[3] * aa[3])};
            *(u32x2*)(BEb + m * 512 + ch) = bo;
            u32x2 ko = {pack2(kv[0] * (1.f + (aa[0] - 1.f) * ka.x), kv[1] * (1.f + (aa[1] - 1.f) * ka.y)),
                        pack2(kv[2] * (1.f + (aa[2] - 1.f) * ka.z), kv[3] * (1.f + (aa[3] - 1.f) * ka.w))};
            *(u32x2*)(Kb + m * 512 + ch) = ko;
          } else {
            u32x2 pk = {pack2(a4[0], a4[1]), pack2(a4[2], a4[3])};
            *(u32x2*)(G16 + m * 512 + ch) = pk;
          }
        }
      }
  }
}

constexpr int SC_TB = 8;
constexpr int SC_WLDS = 6 * SC_TB * 64;
template <int MODE>
DI void scan_chunk(const Params& P, int bh, int c, int lane, float* lds) {
  char* ws = P.ws;
  const int b = bh >> 3, h = bh & 7;
  const size_t tok0 = (size_t)b * S_ + (size_t)c * CH_L;
  const size_t base = tok0 * 512 + h * 64;
  const u16* arh[6] = {(const u16*)(ws + OFF_AL) + base, (const u16*)(ws + OFF_BE) + base, nullptr,
                       (const u16*)P.out + (size_t)T_ * 512 + base, (const u16*)P.out + base, (const u16*)(ws + OFF_V) + base};
  const float* ard = (const float*)(ws + OFF_DD) + base;
  float* PM = (float*)(ws + OFF_PM); float* HM = (float*)(ws + OFF_HM);
  f32x2 SA[32], SB[32];
  if (MODE == 0) {
#pragma unroll
    for (int p = 0; p < 32; ++p) { SA[p].x = (2 * p == lane) ? 1.f : 0.f; SA[p].y = (2 * p + 1 == lane) ? 1.f : 0.f; SB[p].x = 0.f; SB[p].y = 0.f; }
  } else if (c == 0) {
#pragma unroll
    for (int p = 0; p < 32; ++p) { SA[p].x = 0.f; SA[p].y = 0.f; }
  } else {
    const float4* src = (const float4*)(HM + ((size_t)(bh * CH_C + c - 1) * 64 + lane) * 64);
#pragma unroll
    for (int q = 0; q < 16; ++q) { float4 v = src[q]; SA[2 * q].x = v.x; SA[2 * q].y = v.y; SA[2 * q + 1].x = v.z; SA[2 * q + 1].y = v.w; }
  }
  float lng = 0.f, lnb = 0.f, rk = 0.f;
  const u16* G16 = (const u16*)(ws + OFF_G16) + base;
  u16* CAT = (u16*)(ws + OFF_ACT) + tok0 * 1024 + 512 + h * 64;
  if (MODE == 2) { lng = P.rw_ln_g[h * 64 + lane]; lnb = P.rw_ln_b[h * 64 + lane]; rk = P.rw_r_k[h * 64 + lane]; }
  const int st_t = lane >> 4, st_q = (lane & 15) * 4;
#pragma unroll 1
  for (int tb = 0; tb < CH_L / SC_TB; ++tb) {
    {
      u32x4 ph[6]; f32x4 pd[2];
#pragma unroll
      for (int a = 0; a < 6; ++a) {
        if (a == 2 || (MODE == 0 && a == 4)) continue;
        ph[a] = *(const u32x4*)(arh[a] + (size_t)(tb * SC_TB + (lane >> 3)) * 512 + (lane & 7) * 8);
      }
#pragma unroll
      for (int f = 0; f < 2; ++f) pd[f] = *(const f32x4*)(ard + (size_t)(tb * SC_TB + f * 4 + st_t) * 512 + st_q);
#pragma unroll
      for (int a = 0; a < 6; ++a) {
        if (a == 2 || (MODE == 0 && a == 4)) continue;
        float* dst = lds + (a * SC_TB + (lane >> 3)) * 64 + (lane & 7) * 8;
        f32x4 lo = {bflo(ph[a].x), bfhi(ph[a].x), bflo(ph[a].y), bfhi(ph[a].y)}, hi = {bflo(ph[a].z), bfhi(ph[a].z), bflo(ph[a].w), bfhi(ph[a].w)};
        *(f32x4*)dst = lo; *(f32x4*)(dst + 4) = hi;
      }
#pragma unroll
      for (int f = 0; f < 2; ++f) *(f32x4*)(lds + ((4 + f) * 64 + lane) * 4) = pd[f];
    }
#pragma unroll 1
    for (int t = 0; t < SC_TB; ++t) {
      const float* la = lds + t * 64;
      const float vi = la[5 * SC_TB * 64 + lane];
      float gbits = 0.f;
      if (MODE == 2) gbits = __uint_as_float((u32)G16[(size_t)(tb * SC_TB + t) * 512 + lane] << 16);
      f32x2 sa2 = {0.f, 0.f}, sb2 = {0.f, 0.f};
#pragma unroll
      for (int q = 0; q < 16; ++q) {
        if ((q & 3) == 0) asm volatile("" ::: "memory");
        const f32x4 al = *(const f32x4*)(la + 4 * q);
        const f32x2 al0 = {al.x, al.y}, al1 = {al.z, al.w};
        sa2 = SA[2 * q] * al0 + sa2; sa2 = SA[2 * q + 1] * al1 + sa2;
        if (MODE == 0) { sb2 = SB[2 * q] * al0 + sb2; sb2 = SB[2 * q + 1] * al1 + sb2; }
      }
      const float sa = sa2.x + sa2.y, sb = sb2.x + sb2.y;
      const f32x2 sav = {sa, sa}, sbv = {sb, sb}, viv = {vi, vi};
      f32x2 y2 = {0.f, 0.f};
#pragma unroll
      for (int q = 0; q < 16; ++q) {
        if ((q & 1) == 0) asm volatile("" ::: "memory");
        const f32x4 be = *(const f32x4*)(la + 1 * SC_TB * 64 + 4 * q);
        const f32x4 dd = *(const f32x4*)(la + 2 * SC_TB * 64 + 4 * q);
        const f32x4 kk = *(const f32x4*)(la + 3 * SC_TB * 64 + 4 * q);
        const f32x2 be0 = {be.x, be.y}, be1 = {be.z, be.w}, dd0 = {dd.x, dd.y}, dd1 = {dd.z, dd.w}, kk0 = {kk.x, kk.y}, kk1 = {kk.z, kk.w};
        if (MODE == 0) {
          SA[2 * q] = SA[2 * q] * dd0 + sav * be0; SA[2 * q + 1] = SA[2 * q + 1] * dd1 + sav * be1;
          SB[2 * q] = SB[2 * q] * dd0 + (viv * kk0 + sbv * be0); SB[2 * q + 1] = SB[2 * q + 1] * dd1 + (viv * kk1 + sbv * be1);
        } else {
          const f32x4 rr = *(const f32x4*)(la + 4 * SC_TB * 64 + 4 * q);
          const f32x2 rr0 = {rr.x, rr.y}, rr1 = {rr.z, rr.w};
          SA[2 * q] = SA[2 * q] * dd0 + (viv * kk0 + sav * be0); SA[2 * q + 1] = SA[2 * q + 1] * dd1 + (viv * kk1 + sav * be1);
          y2 = SA[2 * q] * rr0 + y2; y2 = SA[2 * q + 1] * rr1 + y2;
        }
      }
      if (MODE == 2) {
        const float y = y2.x + y2.y;
        const float rj = la[4 * SC_TB * 64 + lane], kj = la[3 * SC_TB * 64 + lane];
        const float mean = wave_sum(y) * (1.f / 64.f);
        const float dv = y - mean;
        const float var = wave_sum(dv * dv) * (1.f / 64.f);
        const float bonus = wave_sum(rj * kj * rk);
        float yn = dv * rsqrtf(var + 64e-5f) * lng + lnb;
        yn += bonus * vi;
        CAT[(size_t)(tb * SC_TB + t) * 1024 + lane] = f2bf(yn * gbits);
      }
    }
  }
  if (MODE == 0) {
    float4* dp = (float4*)(PM + ((size_t)(bh * CH_C + c) * 64 + lane) * 64);
    float4* dh = (float4*)(HM + ((size_t)(bh * CH_C + c) * 64 + lane) * 64);
#pragma unroll
    for (int q = 0; q < 16; ++q) {
      dp[q] = make_float4(SA[2 * q].x, SA[2 * q].y, SA[2 * q + 1].x, SA[2 * q + 1].y);
      dh[q] = make_float4(SB[2 * q].x, SB[2 * q].y, SB[2 * q + 1].x, SB[2 * q + 1].y);
    }
  }
}
DI void phase_scan1(const Params& P, char* smem) {
  const int lane = threadIdx.x & 63;
  const int wave = __builtin_amdgcn_readfirstlane((int)(threadIdx.x >> 6));
  float* lds = (float*)smem + wave * SC_WLDS;
  const int nitems = 32 * (CH_C - 1);
  for (int it = blockIdx.x * 4 + wave; it < nitems; it += gridDim.x * 4) scan_chunk<0>(P, it / (CH_C - 1), it % (CH_C - 1), lane, lds);
}
DI void phase_scan2(const Params& P, char* smem) {
  constexpr int SLD = 68;
  float* sA = (float*)smem;
  char* ws = P.ws;
  float* HM = (float*)(ws + OFF_HM); const float* PM = (const float*)(ws + OFF_PM);
  const int lane = threadIdx.x & 63, wave = threadIdx.x >> 6, ib = wave >> 1, jb = wave & 1, r = lane & 31, g = lane >> 5;
  for (int bh = blockIdx.x; bh < 32; bh += gridDim.x) {
    float av[32];
    {
      const float* s0 = HM + ((size_t)(bh * CH_C) * 64 + 32 * ib + r) * 64 + g;
#pragma unroll
      for (int kk = 0; kk < 32; ++kk) av[kk] = s0[2 * kk];
    }
#pragma unroll 1
    for (int c = 1; c <= CH_C - 2; ++c) {
      const float* pb = PM + ((size_t)(bh * CH_C + c) * 64 + g) * 64 + 32 * jb + r;
      float* hb = HM + ((size_t)(bh * CH_C + c) * 64 + 32 * ib + 4 * g) * 64 + 32 * jb + r;
      f32x16 acc;
#pragma unroll
      for (int q = 0; q < 16; ++q) acc[q] = hb[(size_t)((q & 3) + 8 * (q >> 2)) * 64];
      float bv[32];
#pragma unroll
      for (int kk = 0; kk < 32; ++kk) bv[kk] = pb[(size_t)(2 * kk) * 64];
#pragma unroll
      for (int kk = 0; kk < 32; ++kk) acc = __builtin_amdgcn_mfma_f32_32x32x2f32(av[kk], bv[kk], acc, 0, 0, 0);
      const int j = 32 * jb + r;
      __syncthreads();
#pragma unroll
      for (int q = 0; q < 16; ++q) {
        const int il = (q & 3) + 8 * (q >> 2) + 4 * g;
        hb[(size_t)((q & 3) + 8 * (q >> 2)) * 64] = acc[q];
        sA[(32 * ib + il) * SLD + (j & 1) * 32 + (j >> 1)] = acc[q];
      }
      __syncthreads();
#pragma unroll
      for (int k4 = 0; k4 < 8; ++k4) {
        const float4 v = *(const float4*)(sA + (32 * ib + r) * SLD + g * 32 + 4 * k4);
        av[4 * k4] = v.x; av[4 * k4 + 1] = v.y; av[4 * k4 + 2] = v.z; av[4 * k4 + 3] = v.w;
      }
    }
  }
}
DI void phase_scan3(const Params& P, char* smem) {
  const int lane = threadIdx.x & 63;
  const int wave = __builtin_amdgcn_readfirstlane((int)(threadIdx.x >> 6));
  float* lds = (float*)smem + wave * SC_WLDS;
  const int nitems = 32 * CH_C;
  for (int it = blockIdx.x * 4 + wave; it < nitems; it += gridDim.x * 4) scan_chunk<2>(P, it / CH_C, it % CH_C, lane, lds);
}

DI void phase_outproj(const Params& P, char* smem) {
  u16* sW = (u16*)smem; u16* sX = sW + 128 * LDS_LD;
  char* ws = P.ws;
  const u16* Wt = (const u16*)(ws + OFF_WOUTT); const u16* CAT = (const u16*)(ws + OFF_ACT);
  const int lane = threadIdx.x & 63, wave = threadIdx.x >> 6, wn = wave >> 1, wm = wave & 1, r = lane & 31, h = lane >> 5;
  constexpr int NT = 8, MT = 256;
  for (int tile = blockIdx.x; tile < NT * MT; tile += gridDim.x) {
    int mt = tile / NT, nt = tile % NT;
    f32x16 acc[2][2]; zero_acc(acc);
    gemm_tile(acc, Wt + (size_t)nt * 128 * 1024, 1024, CAT + (size_t)mt * 128 * 1024, 1024, 1024, sW, sX);
#pragma unroll
    for (int ai = 0; ai < 2; ++ai)
#pragma unroll
      for (int bi = 0; bi < 2; ++bi) {
        const int nb = nt * 128 + wn * 64 + ai * 32;
        const size_t m = mt * 128 + wm * 64 + bi * 32 + r;
#pragma unroll
        for (int q = 0; q < 4; ++q) {
          const int n = nb + 8 * q + 4 * h;
          float4 xv = *(const float4*)(P.x + m * 1024 + n);
          *(float4*)(P.out + m * 1024 + n) = make_float4(xv.x + acc[ai][bi][4 * q], xv.y + acc[ai][bi][4 * q + 1], xv.z + acc[ai][bi][4 * q + 2], xv.w + acc[ai][bi][4 * q + 3]);
        }
      }
  }
}

DI void phase_qproj(const Params& P, char* smem, int half) {
  u16* sW = (u16*)smem; u16* sX = sW + 128 * LDS_LD;
  char* ws = P.ws;
  const u16* Wt = (const u16*)(ws + OFF_WQT); const u16* A = (const u16*)(ws + OFF_ACT); u16* Q16 = (u16*)(ws + OFF_Q16);
  const int lane = threadIdx.x & 63, wave = threadIdx.x >> 6, wn = wave >> 1, wm = wave & 1, r = lane & 31, h = lane >> 5;
  constexpr int NT = 16, MT = 128;
  for (int tile = blockIdx.x; tile < NT * MT; tile += gridDim.x) {
    int mt = tile / NT, nt = tile % NT;
    f32x16 acc[2][2]; zero_acc(acc);
    gemm_tile(acc, Wt + (size_t)nt * 128 * 1024, 1024, A + (size_t)(half * 128 + mt) * 128 * 1024, 1024, 1024, sW, sX);
#pragma unroll
    for (int ai = 0; ai < 2; ++ai)
#pragma unroll
      for (int bi = 0; bi < 2; ++bi) {
        const int nb = nt * 128 + wn * 64 + ai * 32;
        const size_t m = mt * 128 + wm * 64 + bi * 32 + r;
#pragma unroll
        for (int q = 0; q < 4; ++q) {
          u32x2 pk = {pack2(acc[ai][bi][4 * q], acc[ai][bi][4 * q + 1]), pack2(acc[ai][bi][4 * q + 2], acc[ai][bi][4 * q + 3])};
          *(u32x2*)(Q16 + m * 2048 + nb + 8 * q + 4 * h) = pk;
        }
      }
  }
}
DI void phase_scores(const Params& P, char* smem) {
  u16* sW = (u16*)smem; u16* sX = sW + 128 * LDS_LD;
  char* ws = P.ws;
  const u16* SK = (const u16*)(ws + OFF_SUBK); const u16* Q16 = (const u16*)(ws + OFF_Q16); float* ST = (float*)(ws + OFF_ST);
  const int lane = threadIdx.x & 63, wave = threadIdx.x >> 6, wn = wave >> 1, wm = wave & 1, r = lane & 31, h = lane >> 5;
  for (int tile = blockIdx.x; tile < 16 * 128; tile += gridDim.x) {
    int mt = tile >> 4, hp = tile & 15;
    f32x16 acc[2][2]; zero_acc(acc);
    gemm_tile(acc, SK + (size_t)hp * 128 * 128, 128, Q16 + (size_t)mt * 128 * 2048 + hp * 128, 2048, 128, sW, sX);
#pragma unroll
    for (int ai = 0; ai < 2; ++ai)
#pragma unroll
      for (int bi = 0; bi < 2; ++bi) {
        const int nb = wn * 64 + ai * 32;
        const size_t m = mt * 128 + wm * 64 + bi * 32 + r;
#pragma unroll
        for (int i = 0; i < 16; ++i) ST[((size_t)(hp * 128 + nb + crow(i, h))) * TH_ + m] = acc[ai][bi][i];
      }
  }
}
DI u32 ford(float f) { u32 u = __float_as_uint(f); return u ^ ((u32)((int)u >> 31) | 0x80000000u); }
DI float funord(u32 k) { u32 u = (k & 0x80000000u) ? (k ^ 0x80000000u) : ~k; return __uint_as_float(u); }
DI void ins16(u32 (&L)[16], u32 x) {
#pragma unroll
  for (int k = 0; k < 16; ++k) { u32 hi = max(L[k], x); x = min(L[k], x); L[k] = hi; }
}
DI void phase_topk(const Params& P, int half) {
  char* ws = P.ws;
  const float* ST = (const float*)(ws + OFF_ST); int* IDX = (int*)(ws + OFF_IDX); float* GATE = (float*)(ws + OFF_GATE);
  const int lane = threadIdx.x & 63, wave = threadIdx.x >> 6;
  for (int it = blockIdx.x * 4 + wave; it < (TH_ / 64) * 8; it += gridDim.x * 4) {
    const int hd = it & 7, tl = (it >> 3) * 64 + lane, t = half * TH_ + tl;
    u32 L1[16], L2[16];
#pragma unroll
    for (int k = 0; k < 16; ++k) { L1[k] = 0u; L2[k] = 0u; }
    const float* s1 = ST + ((size_t)(hd * 2) * 128) * TH_ + tl;
    const float* s2 = ST + ((size_t)(hd * 2 + 1) * 128) * TH_ + tl;
#pragma unroll 8
    for (int n = 0; n < 128; ++n) {
      ins16(L1, (ford(s1[(size_t)n * TH_]) & ~127u) | (u32)(127 - n));
      ins16(L2, (ford(s2[(size_t)n * TH_]) & ~127u) | (u32)(127 - n));
    }
    float v1[16], v2[16];
#pragma unroll
    for (int k = 0; k < 16; ++k) { v1[k] = funord(L1[k] & ~127u); v2[k] = funord(L2[k] & ~127u); }
    u32 C[16];
#pragma unroll
    for (int k = 0; k < 16; ++k) C[k] = 0u;
#pragma unroll
    for (int a = 0; a < 16; ++a)
#pragma unroll
      for (int bb = 0; bb < 16; ++bb)
        if ((a + 1) * (bb + 1) <= 16) ins16(C, (ford(v1[a] + v2[bb]) & ~255u) | (u32)(255 - (a * 16 + bb)));
    float best[16]; float den = 0.f;
    const float m0 = funord(C[0] & ~255u);
#pragma unroll
    for (int k = 0; k < 16; ++k) { best[k] = __expf(funord(C[k] & ~255u) - m0); den += best[k]; }
    const float rden = 1.f / den;
#pragma unroll
    for (int k4 = 0; k4 < 4; ++k4) {
      int id[4];
#pragma unroll
      for (int u = 0; u < 4; ++u) {
        const int k = k4 * 4 + u;
        const int ab = 255 - (int)(C[k] & 255u), a = ab >> 4, bb = ab & 15;
        u32 e1 = 0, e2 = 0;
#pragma unroll
        for (int q = 0; q < 16; ++q) { e1 = (a == q) ? L1[q] : e1; e2 = (bb == q) ? L2[q] : e2; }
        id[u] = (127 - (int)(e1 & 127u)) * 128 + (127 - (int)(e2 & 127u));
      }
      *(int4*)(IDX + (size_t)t * 128 + hd * 16 + k4 * 4) = make_int4(id[0], id[1], id[2], id[3]);
      *(float4*)(GATE + (size_t)t * 128 + hd * 16 + k4 * 4) = make_float4(best[k4 * 4] * rden, best[k4 * 4 + 1] * rden, best[k4 * 4 + 2] * rden, best[k4 * 4 + 3] * rden);
    }
  }
}
DI float gelu_(float x) { return 0.5f * x * (1.f + erff(x * 0.70710678118654752f)); }
DI void fp8x16_to_f32(u32x4 v, float (&f)[16]) {
  const u32 w[4] = {v.x, v.y, v.z, v.w};
#pragma unroll
  for (int k = 0; k < 4; ++k) {
    f32x2 lo = __builtin_amdgcn_cvt_pk_f32_fp8((int)w[k], false), hi = __builtin_amdgcn_cvt_pk_f32_fp8((int)w[k], true);
    f[4 * k] = lo.x; f[4 * k + 1] = lo.y; f[4 * k + 2] = hi.x; f[4 * k + 3] = hi.y;
  }
}
DI void phase_gather(const Params& P) {
  char* ws = P.ws;
  const int* IDX = (const int*)(ws + OFF_IDX); const float* GATE = (const float*)(ws + OFF_GATE);
  const unsigned char* PU = (const unsigned char*)(ws + OFF_PU16); const unsigned char* PV = (const unsigned char*)(ws + OFF_PV16);
  u16* ACT = (u16*)(ws + OFF_ACT);
  const int lane = threadIdx.x & 63, wave = threadIdx.x >> 6;
  for (int t = blockIdx.x * 4 + wave; t < T_; t += gridDim.x * 4) {
    const u16* xr = ACT + (size_t)t * 1024 + lane * 16;
    float xf[16];
    {
      const u32x4 x0 = *(const u32x4*)xr, x1 = *(const u32x4*)(xr + 8);
      xf[0] = bflo(x0.x); xf[1] = bfhi(x0.x); xf[2] = bflo(x0.y); xf[3] = bfhi(x0.y); xf[4] = bflo(x0.z); xf[5] = bfhi(x0.z); xf[6] = bflo(x0.w); xf[7] = bfhi(x0.w);
      xf[8] = bflo(x1.x); xf[9] = bfhi(x1.x); xf[10] = bflo(x1.y); xf[11] = bfhi(x1.y); xf[12] = bflo(x1.z); xf[13] = bfhi(x1.z); xf[14] = bflo(x1.w); xf[15] = bfhi(x1.w);
    }
    int id[2]; float gt[2];
    id[0] = IDX[(size_t)t * 128 + lane]; id[1] = IDX[(size_t)t * 128 + 64 + lane];
    gt[0] = GATE[(size_t)t * 128 + lane]; gt[1] = GATE[(size_t)t * 128 + 64 + lane];
    float acc[16];
#pragma unroll
    for (int k = 0; k < 16; ++k) acc[k] = 0.f;
#pragma unroll
    for (int hf = 0; hf < 2; ++hf) {
#pragma unroll 1
      for (int hq = 0; hq < 4; ++hq) {
        u32x4 rec[16];
#pragma unroll
        for (int j = 0; j < 16; ++j) {
          const int row = __builtin_amdgcn_readlane(id[hf], hq * 16 + j);
          rec[j] = *(const u32x4*)(PU + (size_t)row * 1024 + lane * 16);
        }
        float dsel = 0.f;
        const int li = lane & 15;
#pragma unroll
        for (int j = 0; j < 16; ++j) {
          float uf[16]; fp4x8_to_f32(rec[j].x, uf); fp4x8_to_f32(rec[j].y, uf + 8);
          float p0 = 0.f, p1 = 0.f;
#pragma unroll
          for (int k = 0; k < 16; k += 2) { p0 = fmaf(uf[k], xf[k], p0); p1 = fmaf(uf[k + 1], xf[k + 1], p1); }
          float rs = sum8(p0 + p1); rs += dppf<0x140>(rs);
          dsel = (li == j) ? rs : dsel;
        }
        dsel += __shfl_xor(dsel, 16);
        dsel += __shfl_xor(dsel, 32);
        const float wsel = 0.1f * gt[hf] * gelu_(dsel * 0.015625f);
#pragma unroll
        for (int j = 0; j < 16; ++j) {
          const float w = rlf(wsel, hq * 16 + j);
          float vf[16]; fp4x8_to_f32(rec[j].z, vf); fp4x8_to_f32(rec[j].w, vf + 8);
#pragma unroll
          for (int k = 0; k < 16; ++k) acc[k] = fmaf(w, vf[k], acc[k]);
        }
      }
    }
    float* hr = P.out + (size_t)t * 1024 + lane * 16;
    float ss = 0.f;
#pragma unroll
    for (int q = 0; q < 4; ++q) {
      float4 hv = *(const float4*)(hr + 4 * q);
      hv.x += acc[4 * q]; hv.y += acc[4 * q + 1]; hv.z += acc[4 * q + 2]; hv.w += acc[4 * q + 3];
      *(float4*)(hr + 4 * q) = hv;
      acc[4 * q] = hv.x; acc[4 * q + 1] = hv.y; acc[4 * q + 2] = hv.z; acc[4 * q + 3] = hv.w;
      ss += hv.x * hv.x + hv.y * hv.y + hv.z * hv.z + hv.w * hv.w;
    }
    ss = wave_sum(ss);
    const float rs = rsqrtf(ss * (1.f / 1024.f) + 1e-6f);
    const float* g = P.norm_ple_g + lane * 16;
    u32 o[8];
#pragma unroll
    for (int q = 0; q < 4; ++q) {
      float4 gg = *(const float4*)(g + 4 * q);
      o[2 * q] = pack2(acc[4 * q] * rs * gg.x, acc[4 * q + 1] * rs * gg.y); o[2 * q + 1] = pack2(acc[4 * q + 2] * rs * gg.z, acc[4 * q + 3] * rs * gg.w);
    }
    u32x4 o0 = {o[0], o[1], o[2], o[3]}, o1 = {o[4], o[5], o[6], o[7]};
    *(u32x4*)(ACT + (size_t)t * 1024 + lane * 16) = o0; *(u32x4*)(ACT + (size_t)t * 1024 + lane * 16 + 8) = o1;
  }
}
DI void phase_ple(const Params& P, char* smem) {
  u16* sW = (u16*)smem; u16* sX = sW + 128 * LDS_LD;
  char* ws = P.ws;
  const u16* WgT = (const u16*)(ws + OFF_WGT); const u16* WpT = (const u16*)(ws + OFF_WPT);
  const u16* A = (const u16*)(ws + OFF_ACT); const u16* P16 = (const u16*)(ws + OFF_P16);
  const int lane = threadIdx.x & 63, wave = threadIdx.x >> 6, wn = wave >> 1, wm = wave & 1, r = lane & 31, h = lane >> 5;
  constexpr int NT = 8, MT = 256;
  for (int tile = blockIdx.x; tile < NT * MT; tile += gridDim.x) {
    int mt = tile / NT, nt = tile % NT;
    f32x16 acc[2][2], acc2[2][2]; zero_acc(acc); zero_acc(acc2);
    gemm_tile(acc, WgT + (size_t)nt * 128 * 1024, 1024, A + (size_t)mt * 128 * 1024, 1024, 1024, sW, sX);
    gemm_tile(acc2, WpT + (size_t)nt * 128 * 256, 256, P16 + (size_t)mt * 128 * 256, 256, 256, sW, sX);
#pragma unroll
    for (int ai = 0; ai < 2; ++ai)
#pragma unroll
      for (int bi = 0; bi < 2; ++bi) {
        const int nb = nt * 128 + wn * 64 + ai * 32;
        const size_t m = mt * 128 + wm * 64 + bi * 32 + r;
#pragma unroll
        for (int q = 0; q < 4; ++q) {
          const int n = nb + 8 * q + 4 * h;
          float4 hv = *(const float4*)(P.out + m * 1024 + n);
          hv.x += sigmoidf_(acc[ai][bi][4 * q]) * acc2[ai][bi][4 * q];
          hv.y += sigmoidf_(acc[ai][bi][4 * q + 1]) * acc2[ai][bi][4 * q + 1];
          hv.z += sigmoidf_(acc[ai][bi][4 * q + 2]) * acc2[ai][bi][4 * q + 2];
          hv.w += sigmoidf_(acc[ai][bi][4 * q + 3]) * acc2[ai][bi][4 * q + 3];
          *(float4*)(P.out + m * 1024 + n) = hv;
        }
      }
  }
}
DI void phase_final(const Params& P) {
  const int lane = threadIdx.x & 63, wave = threadIdx.x >> 6;
  for (int t = blockIdx.x * 4 + wave; t < T_; t += gridDim.x * 4) {
    float4* row = (float4*)(P.out + (size_t)t * 1024);
    float4 v[4]; float ss = 0.f;
#pragma unroll
    for (int i = 0; i < 4; ++i) { v[i] = row[lane + 64 * i]; ss += v[i].x * v[i].x + v[i].y * v[i].y + v[i].z * v[i].z + v[i].w * v[i].w; }
    ss = wave_sum(ss);
    const float rs = rsqrtf(ss * (1.f / 1024.f) + 1e-6f);
#pragma unroll
    for (int i = 0; i < 4; ++i) {
      float4 g = ((const float4*)P.norm_final_g)[lane + 64 * i];
      row[lane + 64 * i] = make_float4(v[i].x * rs * g.x, v[i].y * rs * g.y, v[i].z * rs * g.z, v[i].w * rs * g.w);
    }
  }
}

#ifndef PH_MASK
#define PH_MASK 0xFFFFFFFFu
#endif
#define PH(n) if ((PH_MASK >> (n)) & 1u)
#define XB_TMO      128
#define XB_XCNT(j)  (256  + 64 * (j))
#define XB_XSUB(j)  (1280 + 64 * (j))
#define XB_XGEN(j)  (2304 + 64 * (j))
#define XB_TOP      3328
#define XB_TOPGEN   3392
#define XCD_BAR_WORDS 3456
#define XB_SPIN_CAP (1u << 18)
#define LAS __attribute__((address_space(3)))

__device__ __forceinline__ unsigned xb_ld(unsigned* p)              { return __hip_atomic_load(p, __ATOMIC_RELAXED, __HIP_MEMORY_SCOPE_AGENT); }
__device__ __forceinline__ unsigned xb_add(unsigned* p, unsigned v) { return __hip_atomic_fetch_add(p, v, __ATOMIC_RELAXED, __HIP_MEMORY_SCOPE_AGENT); }
__device__ __forceinline__ unsigned xb_xcc_id() { return (unsigned)__builtin_amdgcn_s_getreg((3 << 11) | 20) & 0xFu; }
#define XB_SPIN(cond, bar) do { unsigned _sp = 0; while (cond) { __builtin_amdgcn_s_sleep(1); \
    if ((++_sp & 255u) == 0u) { if (xb_ld(&(bar)[XB_TMO])) break; if (_sp > XB_SPIN_CAP) { atomicAdd(&(bar)[XB_TMO], 1u); break; } } } } while (0)

struct XcdBarrier {
    unsigned* bar; unsigned x;
    volatile LAS unsigned* st;
};

__device__ __forceinline__ XcdBarrier xcd_barrier_post(unsigned* bar, volatile LAS unsigned* st) {
    XcdBarrier b; b.bar = bar; b.x = xb_xcc_id(); b.st = st;
    if (threadIdx.x == 0) (void)xb_add(&bar[XB_XCNT(b.x)], 1u);
    return b;
}
__device__ __forceinline__ void xcd_barrier_complete(unsigned* bar, unsigned x, unsigned& nloc, unsigned& nx) {
    const unsigned G = gridDim.x * gridDim.y * gridDim.z;
    unsigned sum, cnt, mine, sp = 0u;
    for (;;) {
        sum = 0u; cnt = 0u; mine = 0u;
#pragma unroll
        for (unsigned j = 0; j < 16; ++j) { const unsigned c = xb_ld(&bar[XB_XCNT(j)]); sum += c; cnt += (c > 0u) ? 1u : 0u; mine = (j == x) ? c : mine; }
        if (sum == G) break;
        __builtin_amdgcn_s_sleep(1);
        if ((++sp & 255u) == 0u) { if (xb_ld(&bar[XB_TMO])) break; if (sp > XB_SPIN_CAP) { atomicAdd(&bar[XB_TMO], 1u); break; } }
    }
    nloc = mine > 0u ? mine : 1u; nx = cnt > 0u ? cnt : 1u;
}

__device__ __forceinline__ void xcd_barrier(const XcdBarrier& b) {
    asm volatile("s_waitcnt vmcnt(0)" ::: "memory");
    __syncthreads();
    if (threadIdx.x == 0) {
        unsigned* bar = b.bar;
        __builtin_amdgcn_s_waitcnt(0);
        unsigned nloc = b.st[0], nx = b.st[1];
        if (nloc == 0u) { xcd_barrier_complete(bar, b.x, nloc, nx); b.st[0] = nloc; b.st[1] = nx; }
        const unsigned old = xb_add(&bar[XB_XSUB(b.x)], 1u);
        const unsigned gen = old / nloc;
        if (old + 1u == (gen + 1u) * nloc) {
            __builtin_amdgcn_fence(__ATOMIC_RELEASE, "agent");
            asm volatile("s_waitcnt vmcnt(0)" ::: "memory");
            const unsigned og = xb_add(&bar[XB_TOP], 1u);
            const unsigned tg = og / nx;
            if (og + 1u == (tg + 1u) * nx) xb_add(&bar[XB_TOPGEN], 1u);
            else XB_SPIN(xb_ld(&bar[XB_TOPGEN]) == tg, bar);
            __builtin_amdgcn_fence(__ATOMIC_ACQUIRE, "agent");
            xb_add(&bar[XB_XGEN(b.x)], 1u);
            asm volatile("s_waitcnt vmcnt(0)" ::: "memory");
        } else {
            XB_SPIN(xb_ld(&bar[XB_XGEN(b.x)]) == gen, bar);
            __builtin_amdgcn_fence(__ATOMIC_ACQUIRE, "agent");
            asm volatile("s_waitcnt vmcnt(0)" ::: "memory");
        }
    }
    __syncthreads();
}

constexpr int SMEM_BYTES = 2 * 2 * 128 * LDS_LD * 2;

__global__ void __launch_bounds__(256, 2) mega(Params P) {
  __shared__ __attribute__((aligned(16))) char smem[SMEM_BYTES];
  cg::grid_group grid = cg::this_grid();
  __shared__ __attribute__((aligned(16))) unsigned xb_st[4];
  if (threadIdx.x < 4) xb_st[threadIdx.x] = 0u;
  __syncthreads();
  XcdBarrier xb = xcd_barrier_post((unsigned*)(P.ws + OFF_CTR + 4096), (volatile LAS unsigned*)xb_st);
#define RUN(n, ...) PH(n) { if (P.ph_lo <= (n) && (n) <= P.ph_hi) { __VA_ARGS__; } } if (P.ph_lo <= (n) && (n) < P.ph_hi) { if ((n) == 0) grid.sync(); else xcd_barrier(xb); }
  RUN(0, phase_prep(P, smem))
  RUN(1, phase_gemm1(P, smem))
  RUN(2, phase_attn(P, smem); phase_rwprep(P))
  RUN(4, phase_lora(P, smem))
  RUN(5, phase_scan1(P, smem))
  RUN(6, phase_scan2(P, smem))
  RUN(7, phase_scan3(P, smem))
  RUN(8, phase_outproj(P, smem); convert_flat(P.p, (u16*)(P.ws + OFF_P16), (size_t)T_ * 256);
         convert_uv_fp4(P.peer_u, P.peer_v, (unsigned char*)(P.ws + OFF_PU16), 64.f, 10.f))
  RUN(9, rmsnorm_rows(P.out, P.norm_ffn_g, (u16*)(P.ws + OFF_ACT)))
  RUN(10, phase_qproj(P, smem, 0))
  RUN(11, phase_scores(P, smem))
  RUN(12, phase_qproj(P, smem, 1); phase_topk(P, 0))
  RUN(14, phase_scores(P, smem))
  RUN(15, phase_topk(P, 1))
  RUN(16, phase_gather(P))
  RUN(17, phase_ple(P, smem))
  RUN(18, phase_final(P))
}

extern "C" void kernel_launch(void* const* d_in, const int* in_sizes, int n_in, void* d_out, int out_size, void* d_ws, size_t ws_size,
                              hipStream_t stream) {
  static int grid_blocks = 0;
  if (!grid_blocks) {
    int dev = 0, cus = 0, per_cu = 0;
    hipGetDevice(&dev);
    hipDeviceGetAttribute(&cus, hipDeviceAttributeMultiprocessorCount, dev);
    hipOccupancyMaxActiveBlocksPerMultiprocessor(&per_cu, mega, 256, 0);
    if (per_cu < 1) per_cu = 1;
    if (per_cu > 2) per_cu = 2;
    grid_blocks = cus * per_cu;
  }
  Params P{};
  const float* const* fi = (const float* const*)d_in;
  P.x = fi[0]; P.p = fi[1]; P.pos = (const int*)d_in[2];
  P.norm_mix_g = fi[3]; P.w_in = fi[4]; P.lam_q1 = fi[5]; P.lam_k1 = fi[6]; P.lam_q2 = fi[7]; P.lam_k2 = fi[8]; P.subln_g = fi[9];
  P.rw_mu = fi[10]; P.rw_w0 = fi[11]; P.rw_w_up = fi[12]; P.rw_a0 = fi[13]; P.rw_a_up = fi[14]; P.rw_g_up = fi[15];
  P.rw_k_k = fi[16]; P.rw_k_a = fi[17]; P.rw_r_k = fi[18]; P.rw_ln_g = fi[19]; P.rw_ln_b = fi[20];
  P.w_out = fi[21]; P.norm_ffn_g = fi[22]; P.peer_w_q = fi[23]; P.peer_sub_keys = fi[24]; P.peer_u = fi[25]; P.peer_v = fi[26];
  P.norm_ple_g = fi[27]; P.ple_gate_w = fi[28]; P.ple_proj_w = fi[29]; P.norm_final_g = fi[30];
  P.out = (float*)d_out; P.ws = (char*)d_ws;
  for (int i = 0; i < 8; ++i) P.inv_freq[i] = (float)pow(500000.0, -(double)i / 8.0);
  hipMemsetAsync((char*)d_ws + OFF_CTR, 0, 32768, stream);
#ifndef ONE_LAUNCH
  for (int ph = 0; ph < 19; ++ph) {
    P.ph_lo = ph; P.ph_hi = ph;
    hipLaunchKernelGGL(mega, dim3(grid_blocks), dim3(256), 0, stream, P);
  }
#else
  P.ph_lo = 0; P.ph_hi = 18;
  void* args[] = {&P};
  hipLaunchCooperativeKernel((void*)mega, dim3(grid_blocks), dim3(256), args, 0, stream);
#endif
}
```
